# Optimizing an MI355X kernel written in HIP

```python
import math
import jax, jax.numpy as jnp
from jax import lax
import numpy as np

D_MODEL = 1024
BATCH = 8
SEQ = 4096
DEPTH = 2

HEAD_DIM = 64
GROUP_WIDTH = D_MODEL // 4
MIX_WIDTH = 4 * GROUP_WIDTH
N_GROUP_HEADS = GROUP_WIDTH // HEAD_DIM
DIFF_HEADS = N_GROUP_HEADS
DIFF_QK_DIM = HEAD_DIM // 2
MLA_HEADS = N_GROUP_HEADS
MLA_NOPE_DIM = HEAD_DIM
MLA_ROPE_DIM = HEAD_DIM // 2
MLA_V_DIM = HEAD_DIM
MLA_Q_RANK = MLA_HEADS * (MLA_NOPE_DIM + MLA_ROPE_DIM)
MLA_KV_RANK = 4 * MLA_V_DIM
GQA_HEADS = N_GROUP_HEADS
GQA_KV_HEADS = GQA_HEADS // 2
GRID_W = 64
DIL_HEADS = N_GROUP_HEADS
DIL_PAIRS = ((128, 1), (512, 4), (2048, 16))
Q_BLOCK = 128
MLP_HIDDEN = 4 * D_MODEL
ROPE_THETA = 10000.0
RMS_EPS = 1e-6
LN_EPS = 1e-5
NEG_INF = -1e30

kernel_name = "hybrid_parallel_head_group_encoder"


def _column_widths():
    a = DIFF_HEADS * 2 * DIFF_QK_DIM
    return [a, a, a,
            MLA_Q_RANK, MLA_KV_RANK, MLA_ROPE_DIM,
            GQA_HEADS * HEAD_DIM, GQA_KV_HEADS * HEAD_DIM, GQA_KV_HEADS * HEAD_DIM,
            DIL_HEADS * HEAD_DIM, DIL_HEADS * HEAD_DIM, DIL_HEADS * HEAD_DIM]


def _split_points():
    pts, acc = [], 0
    for w in _column_widths()[:-1]:
        acc += w
        pts.append(acc)
    return pts


def _alibi_slopes(n):
    return jnp.exp2(-8.0 * (jnp.arange(n, dtype=jnp.float32) + 1.0) / n)


def _rms(x, g):
    xf = x.astype(jnp.float32)
    y = xf * lax.rsqrt(jnp.mean(jnp.square(xf), -1, keepdims=True) + RMS_EPS)
    return y.astype(x.dtype) * g


def _layer_norm(x, g, b):
    xf = x.astype(jnp.float32)
    mu = jnp.mean(xf, -1, keepdims=True)
    var = jnp.mean(jnp.square(xf - mu), -1, keepdims=True)
    return ((xf - mu) * lax.rsqrt(var + LN_EPS)).astype(x.dtype) * g + b


def _rope(x, pos):
    half = x.shape[-1] // 2
    freqs = ROPE_THETA ** (-jnp.arange(half, dtype=jnp.float32) / half)
    ang = pos[:, None] * freqs[None, :]
    cos = jnp.cos(ang)[None, :, None, :]
    sin = jnp.sin(ang)[None, :, None, :]
    xf = x.astype(jnp.float32)
    x1, x2 = xf[..., :half], xf[..., half:]
    return jnp.concatenate([x1 * cos - x2 * sin, x2 * cos + x1 * sin], -1).astype(x.dtype)


def _axial_rope(x, row, col):
    half = x.shape[-1] // 2
    return jnp.concatenate([_rope(x[..., :half], row), _rope(x[..., half:], col)], -1)


def _sweep_query_blocks(fn, *q_arrays):
    bsz, seq = q_arrays[0].shape[:2]
    nb = seq // Q_BLOCK

    def to_blocks(a):
        return jnp.swapaxes(a.reshape(bsz, nb, Q_BLOCK, *a.shape[2:]), 0, 1)

    qpos = jnp.arange(seq, dtype=jnp.int32).reshape(nb, Q_BLOCK)
    out = lax.map(lambda args: fn(*args), (qpos,) + tuple(to_blocks(a) for a in q_arrays))
    out = jnp.swapaxes(out, 0, 1)
    return out.reshape(bsz, seq, *out.shape[3:])


def _diff_attention(q, k, v, lam, subln_g, lambda_init, slopes):
    bsz, seq = q.shape[:2]
    kpos = jnp.arange(seq, dtype=jnp.int32)
    scale = DIFF_QK_DIM ** -0.5

    def block(qpos, qb):
        s = jnp.einsum('bqhcd,bkhcd->bhcqk', qb, k).astype(jnp.float32) * scale
        dist = jnp.abs(qpos[:, None] - kpos[None, :]).astype(jnp.float32)
        s = s - slopes[:, None, None, None] * dist
        p = jax.nn.softmax(s, axis=-1)
        a = p[:, :, 0] - lam * p[:, :, 1]
        return jnp.einsum('bhqk,bkhd->bqhd', a.astype(v.dtype), v)

    o = _sweep_query_blocks(block, q)
    o = _rms(o, subln_g) * (1.0 - lambda_init)
    return o.reshape(bsz, seq, -1)


def _mla(cq, ckv, k_rope, q_norm_g, w_uq, kv_norm_g, w_ukv, pos):
    bsz, seq = cq.shape[:2]
    q = (_rms(cq, q_norm_g) @ w_uq).reshape(bsz, seq, MLA_HEADS, MLA_NOPE_DIM + MLA_ROPE_DIM)
    q_nope, q_pe = q[..., :MLA_NOPE_DIM], _rope(q[..., MLA_NOPE_DIM:], pos)
    kv = (_rms(ckv, kv_norm_g) @ w_ukv).reshape(bsz, seq, MLA_HEADS, MLA_NOPE_DIM + MLA_V_DIM)
    k_nope, v = kv[..., :MLA_NOPE_DIM], kv[..., MLA_NOPE_DIM:]
    k_pe = _rope(k_rope[:, :, None, :], pos)[:, :, 0, :]
    scale = (MLA_NOPE_DIM + MLA_ROPE_DIM) ** -0.5

    def block(qpos, qn, qp):
        s = (jnp.einsum('bqhd,bkhd->bhqk', qn, k_nope)
             + jnp.einsum('bqhd,bkd->bhqk', qp, k_pe)).astype(jnp.float32) * scale
        p = jax.nn.softmax(s, axis=-1)
        return jnp.einsum('bhqk,bkhd->bqhd', p.astype(v.dtype), v)

    return _sweep_query_blocks(block, q_nope, q_pe).reshape(bsz, seq, -1)


def _gqa_axial(q, k, v, q_norm_g, k_norm_g, row, col):
    bsz, seq = q.shape[:2]
    q = _axial_rope(_rms(q, q_norm_g), row, col)
    k = _axial_rope(_rms(k, k_norm_g), row, col)
    q = q.reshape(bsz, seq, GQA_KV_HEADS, GQA_HEADS // GQA_KV_HEADS, HEAD_DIM)
    scale = HEAD_DIM ** -0.5

    def block(qpos, qb):
        s = jnp.einsum('bqngd,bknd->bngqk', qb, k).astype(jnp.float32) * scale
        p = jax.nn.softmax(s, axis=-1)
        return jnp.einsum('bngqk,bknd->bqngd', p.astype(v.dtype), v)

    return _sweep_query_blocks(block, q).reshape(bsz, seq, -1)


def _dilated_attention(q, k, v, slopes):
    bsz, seq = q.shape[:2]
    pad = max((w // (2 * d)) * d for w, d in DIL_PAIRS)
    kp = jnp.pad(k, ((0, 0), (pad, pad), (0, 0), (0, 0)))
    vp = jnp.pad(v, ((0, 0), (pad, pad), (0, 0), (0, 0)))
    scale = HEAD_DIM ** -0.5

    def block(qpos, qb):
        outs, lses = [], []
        for w, d in DIL_PAIRS:
            r = w // (2 * d)
            offs = jnp.arange(-r, r + 1, dtype=jnp.int32) * d
            kidx = qpos[:, None] + offs[None, :]
            valid = (kidx >= 0) & (kidx < seq)
            kg = jnp.take(kp, kidx + pad, axis=1)
            vg = jnp.take(vp, kidx + pad, axis=1)
            s = jnp.einsum('bqhd,bqkhd->bhqk', qb, kg).astype(jnp.float32) * scale
            s = s - slopes[:, None, None] * jnp.abs(offs).astype(jnp.float32)[None, None, :]
            s = jnp.where(valid, s, NEG_INF)
            lse = jax.nn.logsumexp(s, axis=-1, keepdims=True)
            p = jnp.exp(s - lse)
            outs.append(jnp.einsum('bhqk,bqkhd->bqhd', p.astype(vg.dtype), vg))
            lses.append(lse[..., 0])
        wts = jax.nn.softmax(jnp.stack(lses, -1), axis=-1)
        wts = jnp.transpose(wts, (0, 2, 1, 3)).astype(qb.dtype)
        return jnp.einsum('bqhdn,bqhn->bqhd', jnp.stack(outs, -1), wts)

    return _sweep_query_blocks(block, q).reshape(bsz, seq, -1)


def _token_mixers(h, lambda_init, w_in, w_o, diff_lambda, diff_subln_g, mla_q_norm_g, mla_w_uq,
                  mla_kv_norm_g, mla_w_ukv, gqa_q_norm_g, gqa_k_norm_g, pos, row, col,
                  slopes_a, slopes_d):
    bsz, seq, _ = h.shape
    proj = h @ w_in
    (a_q, a_k, a_v, b_cq, b_ckv, b_kr, c_q, c_k, c_v, d_q, d_k, d_v) = jnp.split(
        proj, _split_points(), axis=-1)
    lf = diff_lambda.astype(jnp.float32)
    lam = jnp.exp(jnp.sum(lf[0] * lf[1])) - jnp.exp(jnp.sum(lf[2] * lf[3])) + lambda_init
    y_a = _diff_attention(a_q.reshape(bsz, seq, DIFF_HEADS, 2, DIFF_QK_DIM),
                          a_k.reshape(bsz, seq, DIFF_HEADS, 2, DIFF_QK_DIM),
                          a_v.reshape(bsz, seq, DIFF_HEADS, 2 * DIFF_QK_DIM),
                          lam, diff_subln_g, lambda_init, slopes_a)
    y_b = _mla(b_cq, b_ckv, b_kr, mla_q_norm_g, mla_w_uq, mla_kv_norm_g, mla_w_ukv, pos)
    y_c = _gqa_axial(c_q.reshape(bsz, seq, GQA_HEADS, HEAD_DIM),
                     c_k.reshape(bsz, seq, GQA_KV_HEADS, HEAD_DIM),
                     c_v.reshape(bsz, seq, GQA_KV_HEADS, HEAD_DIM),
                     gqa_q_norm_g, gqa_k_norm_g, row, col)
    y_d = _dilated_attention(d_q.reshape(bsz, seq, DIL_HEADS, HEAD_DIM),
                             d_k.reshape(bsz, seq, DIL_HEADS, HEAD_DIM),
                             d_v.reshape(bsz, seq, DIL_HEADS, HEAD_DIM), slopes_d)
    return jnp.concatenate([y_a, y_b, y_c, y_d], axis=-1) @ w_o


def setup_inputs(seed: int = 0) -> dict:
    key = jax.random.key(seed)
    ks = jax.random.split(key, 22)
    beta = (8 * DEPTH) ** -0.25
    L = DEPTH
    in_cols = sum(_column_widths())

    def nrm(k, shape, scale):
        return jax.random.normal(k, shape, jnp.float32) * scale

    return dict(
        x=nrm(ks[0], (BATCH, SEQ, D_MODEL), 1.0),
        c=nrm(ks[1], (BATCH, D_MODEL), 1.0),
        w_ada=nrm(ks[2], (L, D_MODEL, 6 * D_MODEL), 0.5 * D_MODEL ** -0.5),
        b_ada=nrm(ks[3], (L, 6 * D_MODEL), 0.02),
        w_in=nrm(ks[4], (L, D_MODEL, in_cols), D_MODEL ** -0.5),
        w_o=nrm(ks[5], (L, MIX_WIDTH, D_MODEL), beta * MIX_WIDTH ** -0.5),
        diff_lambda=nrm(ks[6], (L, 4, DIFF_QK_DIM), 0.1),
        diff_subln_g=1.0 + nrm(ks[7], (L, 2 * DIFF_QK_DIM), 0.02),
        mla_q_norm_g=1.0 + nrm(ks[8], (L, MLA_Q_RANK), 0.02),
        mla_w_uq=nrm(ks[9], (L, MLA_Q_RANK, MLA_HEADS * (MLA_NOPE_DIM + MLA_ROPE_DIM)), MLA_Q_RANK ** -0.5),
        mla_kv_norm_g=1.0 + nrm(ks[10], (L, MLA_KV_RANK), 0.02),
        mla_w_ukv=nrm(ks[11], (L, MLA_KV_RANK, MLA_HEADS * (MLA_NOPE_DIM + MLA_V_DIM)), MLA_KV_RANK ** -0.5),
        gqa_q_norm_g=1.0 + nrm(ks[12], (L, HEAD_DIM), 0.02),
        gqa_k_norm_g=1.0 + nrm(ks[13], (L, HEAD_DIM), 0.02),
        ln_attn_g=1.0 + nrm(ks[14], (L, D_MODEL), 0.02),
        ln_attn_b=nrm(ks[15], (L, D_MODEL), 0.02),
        w_up=nrm(ks[16], (L, D_MODEL, MLP_HIDDEN), D_MODEL ** -0.5),
        w_down=nrm(ks[17], (L, MLP_HIDDEN, D_MODEL), beta * MLP_HIDDEN ** -0.5),
        ln_mlp_g=1.0 + nrm(ks[18], (L, D_MODEL), 0.02),
        ln_mlp_b=nrm(ks[19], (L, D_MODEL), 0.02),
    )


def reference(x, c, w_ada, b_ada, w_in, w_o, diff_lambda, diff_subln_g, mla_q_norm_g, mla_w_uq,
              mla_kv_norm_g, mla_w_ukv, gqa_q_norm_g, gqa_k_norm_g, ln_attn_g, ln_attn_b,
              w_up, w_down, ln_mlp_g, ln_mlp_b):
    alpha = (2 * DEPTH) ** 0.25
    seq = x.shape[1]
    rows = seq // GRID_W
    pos = jnp.arange(seq, dtype=jnp.float32)
    row = jnp.repeat(jnp.arange(rows, dtype=jnp.float32), GRID_W)
    col = jnp.tile(jnp.arange(GRID_W, dtype=jnp.float32), rows)
    slopes = _alibi_slopes(DIFF_HEADS + DIL_HEADS)
    slopes_a, slopes_d = slopes[0::2], slopes[1::2]
    cond = jax.nn.silu(c)
    for l in range(DEPTH):
        lambda_init = 0.8 - 0.6 * math.exp(-0.3 * l)
        mod = cond @ w_ada[l] + b_ada[l]
        sh_a, sc_a, g_a, sh_m, sc_m, g_m = [m[:, None, :] for m in jnp.split(mod, 6, axis=-1)]
        h = x * (1.0 + sc_a) + sh_a
        y = _token_mixers(h, lambda_init, w_in[l], w_o[l], diff_lambda[l], diff_subln_g[l],
                          mla_q_norm_g[l], mla_w_uq[l], mla_kv_norm_g[l], mla_w_ukv[l],
                          gqa_q_norm_g[l], gqa_k_norm_g[l], pos, row, col, slopes_a, slopes_d)
        x = _layer_norm(alpha * x + g_a * y, ln_attn_g[l], ln_attn_b[l])
        h = x * (1.0 + sc_m) + sh_m
        u = jnp.square(jax.nn.relu(h @ w_up[l])) @ w_down[l]
        x = _layer_norm(alpha * x + g_m * u, ln_mlp_g[l], ln_mlp_b[l])
    return x
```

```cpp
#include <hip/hip_runtime.h>
#include <hip/hip_cooperative_groups.h>
#include <stdint.h>
#include <cstdio>
namespace cg = cooperative_groups;

#ifndef PROBE_DUP
#define PROBE_DUP 0
#endif
#ifndef MULTI_LAUNCH
#define MULTI_LAUNCH 0
#endif

typedef unsigned short bf16_t;
typedef short bf16x8 __attribute__((ext_vector_type(8)));
typedef short s16x4 __attribute__((ext_vector_type(4)));
typedef float f32x16 __attribute__((ext_vector_type(16)));
typedef float f32x4 __attribute__((ext_vector_type(4)));
typedef float f32x2 __attribute__((ext_vector_type(2)));
typedef unsigned u32x4 __attribute__((ext_vector_type(4)));
typedef unsigned u32x2 __attribute__((ext_vector_type(2)));
typedef __bf16 bf2_t __attribute__((ext_vector_type(2)));
#define DI __device__ __forceinline__

constexpr int NTOK = 32768, SEQ = 4096, DM = 1024, LDP = 2816;
constexpr int C_AQ = 0, C_AK = 256, C_BCQ = 768, C_BCKV = 1152, C_CQ = 1408, C_CK = 1664, C_DQ = 1920, C_DK = 2176, C_DV = 2432, C_BKR = 2688;
constexpr float LOG2E = 1.4426950408889634f;
constexpr float SC_A = 0.17677669529663687f * LOG2E;
constexpr float SC_B = 0.10206207261596575f * LOG2E;
constexpr float SC_C = 0.125f * LOG2E;
constexpr float ALPHA = 1.4142135623730951f;
constexpr int LDS_BYTES = 131072;

struct Params {
  const float *x, *c, *w_ada, *b_ada, *w_in, *w_o, *diff_lambda, *diff_subln_g, *mla_q_norm_g, *mla_w_uq, *mla_kv_norm_g, *mla_w_ukv,
      *gqa_q_norm_g, *gqa_k_norm_g, *ln_attn_g, *ln_attn_b, *w_up, *w_down, *ln_mlp_g, *ln_mlp_b;
  float* out;
  bf16_t *wt_in, *wt_o, *wt_up, *wt_down, *wt_uq, *wt_ukv;
  float *modp, *mod, *rope, *ssq, *dlse, *lnstat;
  unsigned* bar;
  unsigned* nmax;
  bf16_t *H, *proj, *qb, *knb, *vta, *vtb, *vtc, *Y, *U, *dpart;
};

DI int tidx() { int t = __builtin_amdgcn_workitem_id_x(); asm volatile("" : "+v"(t)); return t; }
DI unsigned pk2(float a, float b) { f32x2 v = {a, b}; bf2_t r = __builtin_convertvector(v, bf2_t); return __builtin_bit_cast(unsigned, r); }
DI void st4(bf16_t* p, float a, float b, float c, float d) { u32x2 w = {pk2(a, b), pk2(c, d)}; *(u32x2*)p = w; }
DI f32x16 mfma32(bf16x8 a, bf16x8 b, f32x16 c) { return __builtin_amdgcn_mfma_f32_32x32x16_bf16(a, b, c, 0, 0, 0); }
DI f32x16 zero16() { f32x16 z;
#pragma unroll
  for (int i = 0; i < 16; ++i) z[i] = 0.f; return z; }
DI float max3f(float a, float b, float c) { float d; asm("v_max3_f32 %0, %1, %2, %3" : "=v"(d) : "v"(a), "v"(b), "v"(c)); return d; }
DI float bflo(unsigned u) { return __uint_as_float(u << 16); }
DI float bfhi(unsigned u) { return __uint_as_float(u & 0xffff0000u); }

DI void rope32(f32x16& v, const float* __restrict__ rope, int pos, int lh) {
  const float* t = rope + (size_t)pos * 32 + 8 * lh;
#pragma unroll
  for (int g = 0; g < 2; ++g) {
    const f32x4 c0 = *(const f32x4*)(t + g * 16), c1 = *(const f32x4*)(t + g * 16 + 4);
    float x1, x2;
    x1 = v[4 * g + 0]; x2 = v[4 * g + 8];  v[4 * g + 0] = x1 * c0[0] - x2 * c0[1]; v[4 * g + 8]  = x2 * c0[0] + x1 * c0[1];
    x1 = v[4 * g + 1]; x2 = v[4 * g + 9];  v[4 * g + 1] = x1 * c0[2] - x2 * c0[3]; v[4 * g + 9]  = x2 * c0[2] + x1 * c0[3];
    x1 = v[4 * g + 2]; x2 = v[4 * g + 10]; v[4 * g + 2] = x1 * c1[0] - x2 * c1[1]; v[4 * g + 10] = x2 * c1[0] + x1 * c1[1];
    x1 = v[4 * g + 3]; x2 = v[4 * g + 11]; v[4 * g + 3] = x1 * c1[2] - x2 * c1[3]; v[4 * g + 11] = x2 * c1[2] + x1 * c1[3];
  }
}
DI float ssq16(const f32x16& v) { float s = 0.f;
#pragma unroll
  for (int i = 0; i < 16; ++i) s += v[i] * v[i]; return s; }
DI void store_tile(bf16_t* dst, const f32x16& v, int lh, float sc) {
#pragma unroll
  for (int g = 0; g < 4; ++g) st4(dst + 8 * g + 4 * lh, v[4 * g] * sc, v[4 * g + 1] * sc, v[4 * g + 2] * sc, v[4 * g + 3] * sc);
}

DI void store_rows64(char* ldsw, bf16_t* dst, size_t ld, const f32x16& v0, const f32x16& v1, int lane, float sc) {
  const int lr = lane & 31, lh = lane >> 5;
  char* wr = ldsw + lr * 144 + 8 * lh;
#pragma unroll
  for (int g = 0; g < 4; ++g) {
    u32x2 a = {pk2(v0[4 * g] * sc, v0[4 * g + 1] * sc), pk2(v0[4 * g + 2] * sc, v0[4 * g + 3] * sc)};
    u32x2 b = {pk2(v1[4 * g] * sc, v1[4 * g + 1] * sc), pk2(v1[4 * g + 2] * sc, v1[4 * g + 3] * sc)};
    *(u32x2*)(wr + 16 * g) = a; *(u32x2*)(wr + 64 + 16 * g) = b;
  }
  asm volatile("" ::: "memory");
  const int rr = lane >> 3, pc = lane & 7;
#pragma unroll
  for (int it = 0; it < 4; ++it) {
    const u32x4 d = *(const u32x4*)(ldsw + (it * 8 + rr) * 144 + pc * 16);
    *(u32x4*)(dst + (size_t)(it * 8 + rr) * ld + pc * 8) = d;
  }
  asm volatile("" ::: "memory");
}

#define LAS __attribute__((address_space(3)))
constexpr int G_STAGE = 65536, G_BOFF = 32768;
template <bool VM>
DI void g_compute(f32x16 (&acc)[4][2], const LAS char* buf, int aofs, int bofs, int o0) {
#pragma unroll
  for (int ks = 0; ks < 4; ++ks) {
    const int oo = o0 ^ (ks << 5);
    bf16x8 a[4], b[2];
#pragma unroll
    for (int i = 0; i < 4; ++i) a[i] = *(const LAS bf16x8*)(buf + aofs + i * 4096 + oo);
#pragma unroll
    for (int j = 0; j < 2; ++j) b[j] = *(const LAS bf16x8*)(buf + bofs + j * 4096 + oo);
#pragma unroll
    for (int i = 0; i < 4; ++i)
#pragma unroll
      for (int j = 0; j < 2; ++j) acc[i][j] = VM ? mfma32(a[i], b[j], acc[i][j]) : mfma32(b[j], a[i], acc[i][j]);
  }
}
constexpr int EPI_LDS = G_STAGE;
template <bool VM, class Epi>
DI void gemm_loop(char* lds_g, const bf16_t* __restrict__ A, int lda, const bf16_t* __restrict__ Bt, int ldb, int K, int first, int stride, int total, int npn, int pn0, const Epi& epi) {
  if (first >= total) return;
  LAS char* lds = (LAS char*)lds_g;
  const int tid = tidx(), lane = tid & 63, wid = __builtin_amdgcn_readfirstlane(tid >> 6), wm = wid >> 2, wn = wid & 3, lr = lane & 31, lh = lane >> 5;
  const int grow = lane >> 3, gc = ((lane & 7) ^ ((wid & 1) * 4 + (lane >> 4))) * 8;
  const size_t a64 = (size_t)64 * lda, b64 = (size_t)64 * ldb;
  const bf16_t* gA; const bf16_t* gB;
  auto issue = [&](int kt, int stage) __attribute__((always_inline)) {
    LAS char* sb = lds + stage * G_STAGE + wid * 1024;
#pragma unroll
    for (int e = 0; e < 4; ++e) __builtin_amdgcn_global_load_lds((const unsigned*)(gA + e * a64 + kt * 64), (LAS unsigned*)(sb + e * 8192), 16, 0, 0);
#pragma unroll
    for (int e = 0; e < 4; ++e) __builtin_amdgcn_global_load_lds((const unsigned*)(gB + e * b64 + kt * 64), (LAS unsigned*)(sb + G_BOFF + e * 8192), 16, 0, 0);
  };
  int nk = K >> 6;
  asm volatile("" : "+s"(nk));
  const int swz = (lr >> 1) & 7, o0 = (lh ^ swz) * 16;
  const int aofs = (wm * 128 + lr) * 128, bofs = G_BOFF + (wn * 64 + lr) * 128;
  const bool xmap = (stride == 256) && (npn >= 2) && (total == 128 * npn);
  const int sn = npn < 8 ? npn : 8, sm = 32 / sn, xn = npn / sn, Rm = sm * (8 / xn), xx = first & 7, kk = first >> 3;
  auto tile_of = [&](int it, int& pm_, int& pn_) __attribute__((always_inline)) -> bool {
    if (xmap) { pm_ = it * Rm + (xx / xn) * sm + kk / sn; pn_ = pn0 + (xx % xn) * sn + kk % sn; return pm_ < 128; }
    const int t_ = first + it * stride; pm_ = t_ / npn; pn_ = pn0 + t_ % npn; return t_ < total;
  };
  int it = 0, pm, pn;
  tile_of(0, pm, pn);
  gA = A + (size_t)(pm * 256 + wid * 8 + grow) * lda + gc; gB = Bt + (size_t)(pn * 256 + wid * 8 + grow) * ldb + gc;
  __syncthreads();
  issue(0, 0);
  for (;;) {
    f32x16 acc[4][2];
#pragma unroll
    for (int i = 0; i < 4; ++i)
#pragma unroll
      for (int j = 0; j < 2; ++j) acc[i][j] = zero16();
    asm volatile("s_waitcnt vmcnt(0)" ::: "memory"); __builtin_amdgcn_s_barrier(); asm volatile("" ::: "memory");
    for (int kt = 0; kt < nk; ++kt) {
      if (kt + 1 < nk) issue(kt + 1, (kt + 1) & 1);
      g_compute<VM>(acc, lds + (kt & 1) * G_STAGE, aofs, bofs, o0);
      asm volatile("s_waitcnt vmcnt(0)" ::: "memory");
      __builtin_amdgcn_s_barrier(); asm volatile("" ::: "memory");
    }
    int pm2 = pm, pn2 = pn; const bool has_next = tile_of(it + 1, pm2, pn2);
    if (has_next) { gA = A + (size_t)(pm2 * 256 + wid * 8 + grow) * lda + gc; gB = Bt + (size_t)(pn2 * 256 + wid * 8 + grow) * ldb + gc; issue(0, 0); }
    epi.template run<VM>(acc, pm, pn, wm, wn, lr, lh, lds_g);
    if (!has_next) break;
    ++it; pm = pm2; pn = pn2;
  }
  __syncthreads();
}

struct EpiInProj {
  const Params& p; int layer;
  template <bool VM> DI void run(f32x16 (&acc)[4][2], int pm, int pn, int wm, int wn, int lr, int lh, char* lds) const {
    const int hu = pn * 4 + wn, tok0 = pm * 256 + wm * 128;
    if constexpr (VM) {
      bf16_t* vt = p.vta; const int head = hu - 8, nh = 4;
      const int b = tok0 >> 12, s0 = tok0 & 4095;
#pragma unroll
      for (int i = 0; i < 4; ++i)
#pragma unroll
        for (int j = 0; j < 2; ++j) {
          bf16_t* dst = vt + ((size_t)((b * nh + head) * 64 + j * 32 + lr)) * 4096 + s0 + i * 32 + 4 * lh;
#pragma unroll
          for (int g = 0; g < 4; ++g) st4(dst + 8 * g, acc[i][j][4 * g], acc[i][j][4 * g + 1], acc[i][j][4 * g + 2], acc[i][j][4 * g + 3]);
        }
    } else {
      if (hu == 43) return;
      if (hu == 28 || hu == 29) {
        const int b = tok0 >> 12, s0 = tok0 & 4095;
#pragma unroll
        for (int i = 0; i < 4; ++i)
#pragma unroll
          for (int j = 0; j < 2; ++j)
#pragma unroll
            for (int r = 0; r < 16; ++r) { const int d = j * 32 + (r & 3) + 8 * (r >> 2) + 4 * lh;
              p.vtc[((size_t)((b * 2 + hu - 28) * 64 + d)) * 4096 + s0 + i * 32 + lr] = (bf16_t)(pk2(acc[i][j][r], 0.f) & 0xffffu); }
        return;
      }
#pragma unroll
      for (int i = 0; i < 4; ++i) {
        const int token = tok0 + i * 32 + lr, s = token & 4095;
        f32x16 v0 = acc[i][0], v1 = acc[i][1];
        float sc = 1.f;
        if (hu < 4) sc = SC_A;
        if (hu < 8) {
          float n0 = ssq16(v0), n1 = ssq16(v1);
          n0 += __shfl_xor(n0, 32); n1 += __shfl_xor(n1, 32);
#pragma unroll
          for (int o = 16; o > 0; o >>= 1) { n0 = fmaxf(n0, __shfl_xor(n0, o)); n1 = fmaxf(n1, __shfl_xor(n1, o)); }
          if (lr == 0 && lh == 0) {
            const int bb = token >> 12;
            if (hu < 4) { const int idx = 4096 + ((bb * 4 + hu) * 2) * 32 + (s >> 7);
              atomicMax(p.nmax + idx, __float_as_uint(n0 * SC_A * SC_A)); atomicMax(p.nmax + idx + 32, __float_as_uint(n1 * SC_A * SC_A)); }
            else { const int idx = ((bb * 4 + hu - 4) * 2) * 64 + (s >> 6);
              atomicMax(p.nmax + idx, __float_as_uint(n0)); atomicMax(p.nmax + idx + 64, __float_as_uint(n1)); }
          }
        }
        else if (hu >= 12 && hu < 22) {
          float q = ssq16(v0) + ssq16(v1); q += __shfl_xor(q, 32);
          if (lh == 0) p.ssq[(size_t)token * 16 + (hu - 12)] = q;
        } else if (hu >= 22 && hu < 28) {
          float q = ssq16(v0) + ssq16(v1); q += __shfl_xor(q, 32);
          const float rinv = rsqrtf(q * (1.f / 64.f) + 1e-6f);
          const float* g = (hu < 26 ? p.gqa_q_norm_g : p.gqa_k_norm_g) + layer * 64 + 4 * lh;
#pragma unroll
          for (int gg = 0; gg < 4; ++gg) { const f32x4 g0 = *(const f32x4*)(g + 8 * gg), g1 = *(const f32x4*)(g + 32 + 8 * gg);
#pragma unroll
            for (int e = 0; e < 4; ++e) { v0[4 * gg + e] *= rinv * g0[e]; v1[4 * gg + e] *= rinv * g1[e]; } }
          rope32(v0, p.rope, s >> 6, lh); rope32(v1, p.rope, s & 63, lh);
          if (hu < 26) sc = SC_C;
        } else if (hu >= 30 && hu < 34) sc = SC_C;
        else if (hu == 42) rope32(v0, p.rope, s, lh);
        store_rows64(lds + EPI_LDS + (wm * 4 + wn) * 4608, p.proj + (size_t)(tok0 + i * 32) * LDP + hu * 64, LDP, v0, v1, lh * 32 + lr, sc);
      }
    }
  }
};

template <int KIND> struct EpiMla {
  const Params& p;
  DI bool vm(int hu) const { return KIND == 1 && hu >= 4; }
  template <bool VM> DI void run(f32x16 (&acc)[4][2], int pm, int pn, int wm, int wn, int lr, int lh, char* lds) const {
    float* sR = (float*)(lds + EPI_LDS + 8 * 4608);
    const int tid = tidx();
    if (tid < 256) { const float* q = p.ssq + (size_t)(pm * 256 + tid) * 16; float s;
      if (KIND == 0) { s = ((q[0] + q[1]) + (q[2] + q[3])) + (q[4] + q[5]); s = rsqrtf(s * (1.f / 384.f) + 1e-6f); }
      else { s = (q[6] + q[7]) + (q[8] + q[9]); s = rsqrtf(s * (1.f / 256.f) + 1e-6f); }
      sR[tid] = s; }
    __syncthreads();
    const int hu = pn * 4 + wn, tok0 = pm * 256 + wm * 128;
    if constexpr (VM) {
      const int b = tok0 >> 12, s0 = tok0 & 4095, head = hu - 4;
#pragma unroll
      for (int i = 0; i < 4; ++i)
#pragma unroll
        for (int j = 0; j < 2; ++j) {
          bf16_t* dst = p.vtb + ((size_t)((b * 4 + head) * 64 + j * 32 + lr)) * 4096 + s0 + i * 32 + 4 * lh;
#pragma unroll
          for (int g = 0; g < 4; ++g) { const f32x4 r = *(const f32x4*)(sR + wm * 128 + i * 32 + 8 * g + 4 * lh);
            st4(dst + 8 * g, acc[i][j][4 * g] * r[0], acc[i][j][4 * g + 1] * r[1], acc[i][j][4 * g + 2] * r[2], acc[i][j][4 * g + 3] * r[3]); }
        }
    } else {
#pragma unroll
      for (int i = 0; i < 4; ++i) {
        const int token = tok0 + i * 32 + lr, s = token & 4095;
        const float rinv = sR[wm * 128 + i * 32 + lr];
        f32x16 v0 = acc[i][0] * rinv, v1 = acc[i][1] * rinv;
        if (KIND == 0) {
          if (hu >= 6) continue;
          if (hu >= 4) { rope32(v0, p.rope, s, lh); rope32(v1, p.rope, s, lh); }
          store_rows64(lds + EPI_LDS + (wm * 4 + wn) * 4608, p.qb + (size_t)(tok0 + i * 32) * 384 + hu * 64, 384, v0, v1, lh * 32 + lr, SC_B);
        } else {
          store_rows64(lds + EPI_LDS + (wm * 4 + wn) * 4608, p.knb + (size_t)(tok0 + i * 32) * 256 + hu * 64, 256, v0, v1, lh * 32 + lr, 1.f);
        }
      }
    }
    __syncthreads();
  }
};

struct EpiResid {
  const float* xsrc; float* out; const float* gate;
  const float* stat; const float* lng; const float* lnb;
  template <bool VM> DI void run(f32x16 (&acc)[4][2], int pm, int pn, int wm, int wn, int lr, int lh, char* lds) const {
    const int tok0 = pm * 256 + wm * 128, b = tok0 >> 12, lane = lh * 32 + lr, rr = lane >> 3, pc = lane & 7;
    char* img = lds + EPI_LDS + (wm * 4 + wn) * 4608;
#pragma unroll
    for (int j = 0; j < 2; ++j) {
      const int col = pn * 256 + wn * 64 + j * 32 + pc * 4;
      const f32x4 gt = *(const f32x4*)(gate + b * 6144 + col);
      f32x4 lg = {1.f, 1.f, 1.f, 1.f}, lb = {0.f, 0.f, 0.f, 0.f};
      if (stat) { lg = *(const f32x4*)(lng + col); lb = *(const f32x4*)(lnb + col); }
#pragma unroll
      for (int i = 0; i < 4; ++i) {
#pragma unroll
        for (int g = 0; g < 4; ++g) { const f32x4 v = {acc[i][j][4 * g], acc[i][j][4 * g + 1], acc[i][j][4 * g + 2], acc[i][j][4 * g + 3]}; *(f32x4*)(img + lr * 144 + (8 * g + 4 * lh) * 4) = v; }
        asm volatile("" ::: "memory");
#pragma unroll
        for (int it = 0; it < 4; ++it) {
          const f32x4 a = *(const f32x4*)(img + (it * 8 + rr) * 144 + pc * 16);
          const size_t off = (size_t)(tok0 + i * 32 + it * 8 + rr) * DM + col;
          f32x4 xi = *(const f32x4*)(xsrc + off);
          if (stat) { const f32x2 ms = *(const f32x2*)(stat + (size_t)(tok0 + i * 32 + it * 8 + rr) * 2); xi = (xi - ms[0]) * ms[1] * lg + lb; }
          *(f32x4*)(out + off) = ALPHA * xi + gt * a;
        }
        asm volatile("" ::: "memory");
      }
    }
  }
};
struct EpiUp {
  bf16_t* U;
  template <bool VM> DI void run(f32x16 (&acc)[4][2], int pm, int pn, int wm, int wn, int lr, int lh, char* lds) const {
    const int tok0 = pm * 256 + wm * 128;
#pragma unroll
    for (int i = 0; i < 4; ++i) {
      f32x16 v0, v1;
#pragma unroll
      for (int r = 0; r < 16; ++r) { const float a = fmaxf(acc[i][0][r], 0.f), b = fmaxf(acc[i][1][r], 0.f); v0[r] = a * a; v1[r] = b * b; }
      store_rows64(lds + EPI_LDS + (wm * 4 + wn) * 4608, U + (size_t)(tok0 + i * 32) * 4096 + pn * 256 + wn * 64, 4096, v0, v1, lh * 32 + lr, 1.f);
    }
  }
};

template <int MODE>
DI void attn_unit(char* lds, const Params& p, int layer, int u) {
  constexpr int NKS = MODE == 0 ? 2 : (MODE == 1 ? 6 : 4);
  constexpr int KST = MODE == 1 ? 208 : 144;
  constexpr int VOFF = 64 * KST, VST = 144, BUFSZ = VOFF + 64 * VST;
  const int tid = tidx(), lane = tid & 63, wid = tid >> 6, lr = lane & 31, lh = lane >> 5;
  int b, h, q0, dl = 1, rho = 0, br = 0, L = SEQ, comp = 0;
  if (MODE == 0) { h = u >> 8; b = (u >> 5) & 7; q0 = (u & 31) * 128; comp = wid >> 2; }
  else if (MODE == 1 || MODE == 2) { h = (u >> 4) & 3; b = u >> 6; q0 = (u & 15) * 256; }
  else { br = u >> 9; const int r = u & 511; b = r >> 6; h = (r >> 4) & 3; const int xx = r & 15; dl = 1 << (2 * br); rho = xx & (dl - 1); q0 = (xx >> (2 * br)) * 256; L = SEQ >> (2 * br); }
  const int qrow = (MODE == 0) ? q0 + (wid & 3) * 32 + lr : q0 + wid * 32 + lr;
  const int token = (MODE == 3) ? b * SEQ + rho + dl * qrow : b * SEQ + qrow;
  int NT = (MODE == 3) ? 6 : 64, tlo = 0;
  if (MODE == 0) {
    const float sl2 = exp2f(-(float)(2 * h + 1)) * LOG2E;
    const unsigned* km = p.nmax + ((b * 4 + h) * 2) * 64; const unsigned* qm = p.nmax + 4096 + ((b * 4 + h) * 2) * 32 + (q0 >> 7);
    const float q0n = 1.02f * sqrtf(__uint_as_float(qm[0])), q1n = 1.02f * sqrtf(__uint_as_float(qm[32]));
    const int td = q0 >> 6;
    const float kd0 = sqrtf(fmaxf(__uint_as_float(km[td]), __uint_as_float(km[td + 1]))), kd1 = sqrtf(fmaxf(__uint_as_float(km[64 + td]), __uint_as_float(km[64 + td + 1])));
    const float thr0 = -q0n * kd0 - 40.f, thr1 = -q1n * kd1 - 40.f;
    int lo = td, hi = td + 1;
    for (int T = 0; T < 64; ++T) {
      const int dmin = (T < td) ? (q0 - (64 * T + 63)) : ((T > td + 1) ? (64 * T - (q0 + 127)) : 0);
      const float pen = sl2 * (float)dmin;
      const bool need = (q0n * sqrtf(__uint_as_float(km[T])) - pen >= thr0) || (q1n * sqrtf(__uint_as_float(km[64 + T])) - pen >= thr1);
      if (need) { lo = T < lo ? T : lo; hi = T > hi ? T : hi; }
    }
    tlo = __builtin_amdgcn_readfirstlane(lo); NT = __builtin_amdgcn_readfirstlane(hi - lo + 1);
  }
  bf16x8 qf[NKS];
  if constexpr (MODE == 0) { const bf16_t* q = p.proj + (size_t)token * LDP + C_AQ + h * 64 + comp * 32 + lh * 8;
#pragma unroll
    for (int ks = 0; ks < NKS; ++ks) qf[ks] = *(const bf16x8*)(q + ks * 16); }
  else if constexpr (MODE == 1) { const bf16_t* q = p.qb + (size_t)token * 384 + lh * 8;
#pragma unroll
    for (int ks = 0; ks < 4; ++ks) qf[ks] = *(const bf16x8*)(q + h * 64 + ks * 16);
#pragma unroll
    for (int ks = 4; ks < 6; ++ks) qf[ks] = *(const bf16x8*)(q + 256 + h * 32 + (ks - 4) * 16); }
  else { const bf16_t* q = p.proj + (size_t)token * LDP + (MODE == 2 ? C_CQ : C_DQ) + h * 64 + lh * 8;
#pragma unroll
    for (int ks = 0; ks < NKS; ++ks) qf[ks] = *(const bf16x8*)(q + ks * 16); }
  const bf16_t* vtbase = (MODE == 0) ? p.vta + (size_t)((b * 4 + h) * 64) * 4096 : (MODE == 1) ? p.vtb + (size_t)((b * 4 + h) * 64) * 4096 : p.vtc + (size_t)((b * 2 + (h >> 1)) * 64) * 4096;
  float slope2 = 0.f;
  if (MODE == 0) slope2 = exp2f(-(float)(2 * h + 1)) * LOG2E;
  if (MODE == 3) slope2 = exp2f(-(float)(2 * h + 2)) * LOG2E * (float)dl;
  const int srow = tid >> 3, sc = tid & 7;
  u32x4 kr0, kr2, vr0;
  kr2 = (u32x4){0u, 0u, 0u, 0u};
  auto prefetch = [&](int t) __attribute__((always_inline)) {
    const int key0 = (MODE == 3) ? q0 - 64 + 64 * t : 64 * (tlo + t);
    if (MODE != 3) {
      const size_t tokk = (size_t)(b * SEQ + key0 + srow);
      const bf16_t* kp = (MODE == 0) ? p.proj + tokk * LDP + C_AK + h * 64 : (MODE == 1) ? p.knb + tokk * 256 + h * 64 : p.proj + tokk * LDP + C_CK + (h >> 1) * 64;
      kr0 = *(const u32x4*)(kp + sc * 8);
      if (MODE == 1) kr2 = *(const u32x4*)(p.proj + tokk * LDP + C_BKR + (sc & 3) * 8);
      vr0 = *(const u32x4*)(vtbase + (size_t)srow * 4096 + key0 + sc * 8);
    } else {
      int v = key0 + srow; v = v < 0 ? 0 : (v >= L ? L - 1 : v);
      const bf16_t* kp = p.proj + (size_t)(b * SEQ + rho + dl * v) * LDP + h * 64;
      kr0 = *(const u32x4*)(kp + C_DK + sc * 8);
      vr0 = *(const u32x4*)(kp + C_DV + sc * 8);
    }
  };
  auto stage = [&](char* buf) __attribute__((always_inline)) {
    char* kd = buf + srow * KST + sc * 16;
    *(u32x4*)kd = kr0;
    if (MODE == 1) { if (sc < 4) *(u32x4*)(buf + srow * KST + 128 + sc * 16) = kr2; }
    if (MODE != 3) { *(u32x4*)(buf + VOFF + srow * VST + sc * 16) = vr0; }
    else {
      bf16_t* vd = (bf16_t*)(buf + VOFF) + srow;
#pragma unroll
      for (int e = 0; e < 4; ++e) { vd[(sc * 8 + 2 * e) * 72] = (bf16_t)(vr0[e] & 0xffffu); vd[(sc * 8 + 2 * e + 1) * 72] = (bf16_t)(vr0[e] >> 16); }
    }
  };
  f32x16 O0 = zero16(), O1 = zero16();
  float m = -1e30f, l = 0.f;
  f32x16 T0 = zero16(), T1 = zero16();
  if (MODE == 0) {
#pragma unroll
    for (int r = 0; r < 16; ++r) { const float cc = (float)((r & 3) + 8 * (r >> 2)); T0[r] = slope2 * cc; T1[r] = slope2 * (cc + 32.f); }
  }
  const int qlo = q0 + (wid & 3) * 32;
  prefetch(0);
  __syncthreads();
  stage(lds);
  prefetch(1);
  __syncthreads();
  for (int t = 0; t < NT; ++t) {
    char* cur = lds + (t & 1) * BUFSZ;
    if (t + 1 < NT) { stage(lds + ((t + 1) & 1) * BUFSZ); if (t + 2 < NT) prefetch(t + 2); }
    const int key0 = (MODE == 3) ? q0 - 64 + 64 * t : 64 * (tlo + t);
    const bool act = (MODE != 3) || (t >= (wid >> 1) && t <= (wid >> 1) + 2);
    if (act) {
      f32x16 S0 = zero16(), S1 = zero16();
      const char* kb = cur + lr * KST + (MODE == 0 ? comp * 64 : 0) + lh * 16;
#pragma unroll
      for (int ks = 0; ks < NKS; ++ks) {
        const bf16x8 k0 = *(const bf16x8*)(kb + ks * 32), k1 = *(const bf16x8*)(kb + 32 * KST + ks * 32);
        S0 = mfma32(k0, qf[ks], S0); S1 = mfma32(k1, qf[ks], S1);
      }
      float aoff = 0.f;
      if (MODE == 0) {
        const float dbase = (float)(key0 + 4 * lh - qrow);
        if (key0 > qlo + 31) { S0 = S0 - T0; S1 = S1 - T1; aoff = -slope2 * dbase; }
        else if (key0 + 63 < qlo) { S0 = S0 + T0; S1 = S1 + T1; aoff = slope2 * dbase; }
        else {
#pragma unroll
          for (int r = 0; r < 16; ++r) { const float cc = (float)((r & 3) + 8 * (r >> 2));
            S0[r] = fmaf(-slope2, fabsf(dbase + cc), S0[r]); S1[r] = fmaf(-slope2, fabsf(dbase + cc + 32.f), S1[r]); }
        }
      }
      if (MODE == 3) {
        const int rel0 = key0 + 4 * lh - qrow;
#pragma unroll
        for (int r = 0; r < 16; ++r) { const int cc = (r & 3) + 8 * (r >> 2);
          { const int rel = rel0 + cc, v = qrow + rel; const bool ok = (rel >= -64) && (rel <= 64) && (v >= 0) && (v < L); S0[r] = ok ? fmaf(-slope2, fabsf((float)rel), S0[r]) : -1e30f; }
          { const int rel = rel0 + cc + 32, v = qrow + rel; const bool ok = (rel >= -64) && (rel <= 64) && (v >= 0) && (v < L); S1[r] = ok ? fmaf(-slope2, fabsf((float)rel), S1[r]) : -1e30f; } }
      }
      float mx = fmaxf(S0[0], S1[0]);
#pragma unroll
      for (int r = 1; r < 16; ++r) mx = max3f(mx, S0[r], S1[r]);
      mx += aoff;
      if (__any(mx > m + 8.f)) {
        mx = fmaxf(mx, __shfl_xor(mx, 32));
        const float mnew = fmaxf(m, mx);
        const float al = __builtin_amdgcn_exp2f(m - mnew); l *= al; O0 *= al; O1 *= al;
        m = mnew;
      }
      { const f32x2 nm = {aoff - m, aoff - m};
#pragma unroll
        for (int r = 0; r < 8; ++r) {
          f32x2 a = {S0[2 * r], S0[2 * r + 1]}, b = {S1[2 * r], S1[2 * r + 1]};
          asm("v_pk_add_f32 %0, %1, %2" : "=v"(a) : "v"(a), "v"(nm));
          asm("v_pk_add_f32 %0, %1, %2" : "=v"(b) : "v"(b), "v"(nm));
          S0[2 * r] = a[0]; S0[2 * r + 1] = a[1]; S1[2 * r] = b[0]; S1[2 * r + 1] = b[1];
        } }
#pragma unroll
      for (int r = 0; r < 16; ++r) { S0[r] = __builtin_amdgcn_exp2f(S0[r]); S1[r] = __builtin_amdgcn_exp2f(S1[r]); }
      const f32x16 SS = S0 + S1;
      float ps = 0.f;
#pragma unroll
      for (int r = 0; r < 16; ++r) ps += SS[r];
      l += ps;
      bf16x8 pf[4];
#pragma unroll
      for (int s = 0; s < 4; ++s) {
        u32x4 w;
        if (s < 2) { w[0] = pk2(S0[8 * s], S0[8 * s + 1]); w[1] = pk2(S0[8 * s + 2], S0[8 * s + 3]); w[2] = pk2(S0[8 * s + 4], S0[8 * s + 5]); w[3] = pk2(S0[8 * s + 6], S0[8 * s + 7]); }
        else { const int s2 = s - 2; w[0] = pk2(S1[8 * s2], S1[8 * s2 + 1]); w[1] = pk2(S1[8 * s2 + 2], S1[8 * s2 + 3]); w[2] = pk2(S1[8 * s2 + 4], S1[8 * s2 + 5]); w[3] = pk2(S1[8 * s2 + 6], S1[8 * s2 + 7]); }
        pf[s] = __builtin_bit_cast(bf16x8, w);
      }
      const char* vb = cur + VOFF + lr * VST + lh * 8;
#pragma unroll
      for (int s = 0; s < 4; ++s) {
        { const s16x4 lo = *(const s16x4*)(vb + s * 32), hi = *(const s16x4*)(vb + s * 32 + 16);
          O0 = mfma32(__builtin_shufflevector(lo, hi, 0, 1, 2, 3, 4, 5, 6, 7), pf[s], O0); }
        { const s16x4 lo = *(const s16x4*)(vb + 32 * VST + s * 32), hi = *(const s16x4*)(vb + 32 * VST + s * 32 + 16);
          O1 = mfma32(__builtin_shufflevector(lo, hi, 0, 1, 2, 3, 4, 5, 6, 7), pf[s], O1); }
      }
    }
    __syncthreads();
  }
  l += __shfl_xor(l, 32);
  const float inv = 1.f / l;
  O0 *= inv; O1 *= inv;
  if (MODE == 1 || MODE == 2) {
    bf16_t* dst = p.Y + (size_t)token * DM + (MODE == 1 ? 256 : 512) + h * 64;
    store_tile(dst, O0, lh, 1.f); store_tile(dst + 32, O1, lh, 1.f);
  } else if (MODE == 3) {
    bf16_t* dst = p.dpart + ((size_t)br * NTOK + token) * 256 + h * 64;
    store_tile(dst, O0, lh, 1.f); store_tile(dst + 32, O1, lh, 1.f);
    if (lh == 0) p.dlse[((size_t)br * NTOK + token) * 4 + h] = m + log2f(l);
  } else {
    float* xb = (float*)lds + (wid & 3) * 2048 + lane;
    if (comp == 1) {
#pragma unroll
      for (int r = 0; r < 16; ++r) { xb[r * 64] = O0[r]; xb[(16 + r) * 64] = O1[r]; }
    }
    __syncthreads();
    if (comp == 0) {
      const float* dlm = p.diff_lambda + layer * 128;
      float s1 = 0.f, s2 = 0.f;
      for (int i = 0; i < 32; ++i) { s1 += dlm[i] * dlm[32 + i]; s2 += dlm[64 + i] * dlm[96 + i]; }
      const float lambda_init = 0.8f - 0.6f * expf(-0.3f * (float)layer);
      const float lam = expf(s1) - expf(s2) + lambda_init;
      float q = 0.f;
#pragma unroll
      for (int r = 0; r < 16; ++r) { O0[r] -= lam * xb[r * 64]; O1[r] -= lam * xb[(16 + r) * 64]; q += O0[r] * O0[r] + O1[r] * O1[r]; }
      q += __shfl_xor(q, 32);
      const float rinv = rsqrtf(q * (1.f / 64.f) + 1e-6f) * (1.f - lambda_init);
      const float* g = p.diff_subln_g + layer * 64 + 4 * lh;
#pragma unroll
      for (int gg = 0; gg < 4; ++gg) { const f32x4 g0 = *(const f32x4*)(g + 8 * gg), g1 = *(const f32x4*)(g + 32 + 8 * gg);
#pragma unroll
        for (int e = 0; e < 4; ++e) { O0[4 * gg + e] *= rinv * g0[e]; O1[4 * gg + e] *= rinv * g1[e]; } }
      bf16_t* dst = p.Y + (size_t)token * DM + h * 64;
      store_tile(dst, O0, lh, 1.f); store_tile(dst + 32, O1, lh, 1.f);
    }
  }
}

DI void attn_d6_unit(char* lds, const Params& p, int layer, int u) {
  constexpr int KST = 144, VOFF = 384 * KST;
  const int tid = tidx(), lane = tid & 63, wid = tid >> 6, lr = lane & 31, lh = lane >> 5;
  const int br = u >> 9, r = u & 511, b = r >> 6, h = (r >> 4) & 3, xx = r & 15, dl = 1 << (2 * br), rho = xx & (dl - 1), q0 = (xx >> (2 * br)) * 256, L = SEQ >> (2 * br);
  const int qrow = q0 + wid * 32 + lr, token = b * SEQ + rho + dl * qrow;
  bf16x8 qf[4];
  { const bf16_t* q = p.proj + (size_t)token * LDP + C_DQ + h * 64 + lh * 8;
#pragma unroll
    for (int ks = 0; ks < 4; ++ks) qf[ks] = *(const bf16x8*)(q + ks * 16); }
  const float slope2 = exp2f(-(float)(2 * h + 2)) * LOG2E * (float)dl;
  const int srow = tid >> 3, sc = tid & 7;
  u32x4 kr[6], vr[6];
#pragma unroll
  for (int c = 0; c < 6; ++c) {
    int v = q0 - 64 + 64 * c + srow; v = v < 0 ? 0 : (v >= L ? L - 1 : v);
    const bf16_t* kp = p.proj + (size_t)(b * SEQ + rho + dl * v) * LDP + h * 64 + sc * 8;
    kr[c] = *(const u32x4*)(kp + C_DK); vr[c] = *(const u32x4*)(kp + C_DV);
  }
  __syncthreads();
#pragma unroll
  for (int c = 0; c < 6; ++c) {
    *(u32x4*)(lds + (64 * c + srow) * KST + sc * 16) = kr[c];
    *(u32x4*)(lds + VOFF + (64 * c + srow) * KST + sc * 16) = vr[c];
  }
  __syncthreads();
  f32x16 O0 = zero16(), O1 = zero16();
  float m = -1e30f, l = 0.f;
#pragma unroll 1
  for (int c = wid >> 1; c <= (wid >> 1) + 2; ++c) {
    const int key0 = q0 - 64 + 64 * c;
    f32x16 S0 = zero16(), S1 = zero16();
    const char* kb = lds + (64 * c + lr) * KST + lh * 16;
#pragma unroll
    for (int ks = 0; ks < 4; ++ks) {
      const bf16x8 k0 = *(const bf16x8*)(kb + ks * 32), k1 = *(const bf16x8*)(kb + 32 * KST + ks * 32);
      S0 = mfma32(k0, qf[ks], S0); S1 = mfma32(k1, qf[ks], S1);
    }
    const int rel0 = key0 + 4 * lh - qrow;
#pragma unroll
    for (int r2 = 0; r2 < 16; ++r2) { const int cc = (r2 & 3) + 8 * (r2 >> 2);
      { const int rel = rel0 + cc, v = qrow + rel; const bool ok = (rel >= -64) && (rel <= 64) && (v >= 0) && (v < L); S0[r2] = ok ? fmaf(-slope2, fabsf((float)rel), S0[r2]) : -1e30f; }
      { const int rel = rel0 + cc + 32, v = qrow + rel; const bool ok = (rel >= -64) && (rel <= 64) && (v >= 0) && (v < L); S1[r2] = ok ? fmaf(-slope2, fabsf((float)rel), S1[r2]) : -1e30f; } }
    float mx = fmaxf(S0[0], S1[0]);
#pragma unroll
    for (int r2 = 1; r2 < 16; ++r2) mx = max3f(mx, S0[r2], S1[r2]);
    if (__any(mx > m + 8.f)) {
      mx = fmaxf(mx, __shfl_xor(mx, 32));
      const float mnew = fmaxf(m, mx);
      const float al = __builtin_amdgcn_exp2f(m - mnew); l *= al; O0 *= al; O1 *= al;
      m = mnew;
    }
#pragma unroll
    for (int r2 = 0; r2 < 16; ++r2) { S0[r2] = __builtin_amdgcn_exp2f(S0[r2] - m); S1[r2] = __builtin_amdgcn_exp2f(S1[r2] - m); }
    const f32x16 SS = S0 + S1;
    float ps = 0.f;
#pragma unroll
    for (int r2 = 0; r2 < 16; ++r2) ps += SS[r2];
    l += ps;
    bf16x8 pf[4];
#pragma unroll
    for (int s2 = 0; s2 < 4; ++s2) {
      u32x4 w;
      if (s2 < 2) { w[0] = pk2(S0[8 * s2], S0[8 * s2 + 1]); w[1] = pk2(S0[8 * s2 + 2], S0[8 * s2 + 3]); w[2] = pk2(S0[8 * s2 + 4], S0[8 * s2 + 5]); w[3] = pk2(S0[8 * s2 + 6], S0[8 * s2 + 7]); }
      else { const int s3 = s2 - 2; w[0] = pk2(S1[8 * s3], S1[8 * s3 + 1]); w[1] = pk2(S1[8 * s3 + 2], S1[8 * s3 + 3]); w[2] = pk2(S1[8 * s3 + 4], S1[8 * s3 + 5]); w[3] = pk2(S1[8 * s3 + 6], S1[8 * s3 + 7]); }
      pf[s2] = __builtin_bit_cast(bf16x8, w);
    }
    { const int g = lane >> 4, i16 = lane & 15;
      const unsigned vbase = (unsigned)(size_t)(lds + VOFF) + (unsigned)((64 * c + 4 * (g >> 1) + (i16 >> 2)) * KST + ((g & 1) * 16 + 4 * (i16 & 3)) * 2);
#pragma unroll
      for (int s2 = 0; s2 < 4; ++s2) {
        s16x4 l0, h0, l1, h1;
        const unsigned a0 = vbase + (unsigned)(16 * s2 * KST), a1 = a0 + 8u * KST, a2 = a0 + 64u, a3 = a1 + 64u;
        asm volatile("ds_read_b64_tr_b16 %0, %4\n\tds_read_b64_tr_b16 %1, %5\n\tds_read_b64_tr_b16 %2, %6\n\tds_read_b64_tr_b16 %3, %7\n\ts_waitcnt lgkmcnt(0)"
                     : "=&v"(l0), "=&v"(h0), "=&v"(l1), "=&v"(h1) : "v"(a0), "v"(a1), "v"(a2), "v"(a3) : "memory");
        O0 = mfma32(__builtin_shufflevector(l0, h0, 0, 1, 2, 3, 4, 5, 6, 7), pf[s2], O0);
        O1 = mfma32(__builtin_shufflevector(l1, h1, 0, 1, 2, 3, 4, 5, 6, 7), pf[s2], O1);
      } }
  }
  l += __shfl_xor(l, 32);
  const float inv = 1.f / l;
  O0 *= inv; O1 *= inv;
  bf16_t* dst = p.dpart + ((size_t)br * NTOK + token) * 256 + h * 64;
  store_tile(dst, O0, lh, 1.f); store_tile(dst + 32, O1, lh, 1.f);
  if (lh == 0) p.dlse[((size_t)br * NTOK + token) * 4 + h] = m + log2f(l);
}

DI void dcombine_unit(const Params& p, int u) {
#pragma unroll
  for (int e = 0; e < 2; ++e) {
    const int idx = u * 1024 + e * 512 + tidx(), token = idx >> 5, rem = idx & 31, h = rem >> 3, dc = rem & 7;
    float ls[3], mx = -1e30f;
#pragma unroll
    for (int n = 0; n < 3; ++n) { ls[n] = p.dlse[((size_t)n * NTOK + token) * 4 + h]; mx = fmaxf(mx, ls[n]); }
    float w[3], ws = 0.f;
#pragma unroll
    for (int n = 0; n < 3; ++n) { w[n] = exp2f(ls[n] - mx); ws += w[n]; }
    const float inv = 1.f / ws;
    float o[8];
#pragma unroll
    for (int i = 0; i < 8; ++i) o[i] = 0.f;
#pragma unroll
    for (int n = 0; n < 3; ++n) { const u32x4 d = *(const u32x4*)(p.dpart + ((size_t)n * NTOK + token) * 256 + h * 64 + dc * 8); const float wn = w[n] * inv;
#pragma unroll
      for (int i = 0; i < 4; ++i) { o[2 * i] += wn * bflo(d[i]); o[2 * i + 1] += wn * bfhi(d[i]); } }
    u32x4 r = {pk2(o[0], o[1]), pk2(o[2], o[3]), pk2(o[4], o[5]), pk2(o[6], o[7])};
    *(u32x4*)(p.Y + (size_t)token * DM + 768 + h * 64 + dc * 8) = r;
  }
}


namespace pg8 {
#define PG8_LAS __attribute__((address_space(3)))
typedef unsigned short bf16_t;
typedef short bf16x8 __attribute__((ext_vector_type(8)));
typedef float f32x4 __attribute__((ext_vector_type(4)));
typedef unsigned u32x4 __attribute__((ext_vector_type(4)));
constexpr int BM = 256, BK = 64, HALF = 128, HTB = HALF * BK * 2  , STAGE_BYTES = 8 * HTB, NXCD = 8, WGM = 8;

__host__ __device__ __forceinline__ int lds_byte(int r, int c) { const int st = (r >> 4) * 2 + (c >> 5), rr = r & 15, cc = c & 31, ob = rr * 64 + cc * 2; return st * 1024 + (ob ^ (((ob >> 9) & 1) << 5)); }
__host__ __device__ __forceinline__ void stage_rc(int b, int& R, int& C) { const int st = b / 1024, sb = b % 1024, swz = sb ^ (((sb >> 9) & 1) << 5); R = (st >> 1) * 16 + swz / 64; C = (st & 1) * 32 + (swz % 64) / 2; }
__host__ __device__ __forceinline__ int perm32(int rho) { const int n = rho >> 4, i = rho & 15; return 8 * (i >> 2) + 4 * n + (i & 3); }

struct Unit { int pm, pn; };
struct Gemm { const bf16_t* A; const bf16_t* Bt; int M, N, K; };

struct StaticOrder {
    int nM, nN, nwg, G, c;
    __host__ __device__ void init(int M, int N, int G_, int c_) { nM = M / BM; nN = N / BM; nwg = nM * nN; G = G_; c = c_; }
    __host__ __device__ bool next(int i, Unit& u) const {
        const long L = (long)i * G + c; if (L >= nwg) return false;
        int wgid = (int)L; { const int q = nwg / NXCD, r = nwg % NXCD, xcd = wgid % NXCD, off = wgid / NXCD; wgid = (xcd < r ? xcd * (q + 1) : r * (q + 1) + (xcd - r) * q) + off; }
        const int nig = WGM * nN, gid = wgid / nig, fm = gid * WGM, gsz = (nM - fm) < WGM ? (nM - fm) : WGM;
        u.pm = fm + ((wgid % nig) % gsz); u.pn = (wgid % nig) / gsz; return true;
    }
    __device__ __forceinline__ void a_ready(const Unit&) const {}
    __device__ __forceinline__ void done(const Unit&) const {}
};

typedef float f32x2 __attribute__((ext_vector_type(2)));
template <class Epi, class Sched, bool ALIGN_EPI = false, bool SP2 = false, bool VM = false>
__device__ __forceinline__ void gemm_phase(PG8_LAS unsigned char* lds, const Gemm g, const Sched& S, const Epi& E) {
    const int tid = tidx(), wid = __builtin_amdgcn_readfirstlane(tid >> 6), lane = tid & 63, wr = wid >> 2, wc = wid & 3, fr = lane & 15, fq = lane >> 4;
    const int K = g.K, nt = K / BK;
    unsigned voffA[2], voffB[2];
#pragma unroll
    for (int i = 0; i < 2; ++i) { int R, C; stage_rc(tid * 16 + i * 8192, R, C); const int Rb = Epi::PERM ? ((R & ~31) + perm32(R & 31)) : R;
        voffA[i] = (unsigned)(R * K + C) * 2u; voffB[i] = (unsigned)(Rb * K + C) * 2u; }
    const size_t kstep = (size_t)(BK * 2);
    const size_t hstep = (size_t)HALF * K * 2;
    const size_t tstep = 2 * hstep;
    const unsigned ldsw = (unsigned)wid * 1024u;
    const int aoff = lds_byte(wr * 64 + fr, fq * 8), boff = lds_byte(wc * 32 + fr, fq * 8);
#define PG8_SA(b, h) (((b) * 2 + (h)) * HTB)
#define PG8_SB(b, h) ((4 + (b) * 2 + (h)) * HTB)
#define PG8_STAGE(bufoff, gbase, voff) do { _Pragma("unroll") for (int _i = 0; _i < 2; ++_i) \
        __builtin_amdgcn_global_load_lds((const unsigned*)((const char*)(gbase) + (voff)[_i]), (PG8_LAS unsigned*)(lds + (bufoff) + ldsw + _i * 8192), 16, 0, 0); } while (0)
#define PG8_LDA(dst, b, h) do { _Pragma("unroll") for (int m = 0; m < 4; ++m) _Pragma("unroll") for (int k = 0; k < 2; ++k) dst[m][k] = *(const PG8_LAS bf16x8*)(lds + PG8_SA(b, h) + aoff + m * 2048 + k * 1024); } while (0)
#define PG8_LDB(dst, b, h) do { _Pragma("unroll") for (int n = 0; n < 2; ++n) _Pragma("unroll") for (int k = 0; k < 2; ++k) dst[n][k] = *(const PG8_LAS bf16x8*)(lds + PG8_SB(b, h) + boff + n * 2048 + k * 1024); } while (0)
#define PG8_MMA(ai, bj, At, Bt) do { __builtin_amdgcn_s_setprio(1); _Pragma("unroll") for (int m = 0; m < 4; ++m) _Pragma("unroll") for (int n = 0; n < 2; ++n) _Pragma("unroll") for (int k = 0; k < 2; ++k) \
        acc[ai][bj][m][n] = VM ? __builtin_amdgcn_mfma_f32_16x16x32_bf16(At[m][k], Bt[n][k], acc[ai][bj][m][n], 0, 0, 0) : __builtin_amdgcn_mfma_f32_16x16x32_bf16(Bt[n][k], At[m][k], acc[ai][bj][m][n], 0, 0, 0); __builtin_amdgcn_s_setprio(0); } while (0)
#define PG8_WAIT_V(n) asm volatile("s_waitcnt vmcnt(" #n ")" ::: "memory")
#define PG8_WAIT_L(n) asm volatile("s_waitcnt lgkmcnt(" #n ")" ::: "memory")
#define PG8_BAR __builtin_amdgcn_s_barrier()
#define PG8_SCHED __builtin_amdgcn_sched_barrier(0)
    Unit cur, nxt; int ui = 0;
    if (!S.next(0, cur)) return;
    f32x4 acc[2][2][4][2];
#pragma unroll
    for (int a = 0; a < 2; ++a)
#pragma unroll
        for (int b = 0; b < 2; ++b)
#pragma unroll
            for (int m = 0; m < 4; ++m)
#pragma unroll
                for (int n = 0; n < 2; ++n) acc[a][b][m][n] = (f32x4){0.f, 0.f, 0.f, 0.f};
    bf16x8 At[4][2], B0[2][2], B1[2][2];
    const char* cA = (const char*)g.A + (size_t)cur.pm * tstep; const char* cB = (const char*)g.Bt + (size_t)cur.pn * tstep;
    S.a_ready(cur);
    if constexpr (SP2) {
        PG8_STAGE(PG8_SB(0, 0), cB, voffB); PG8_STAGE(PG8_SB(0, 1), cB + hstep, voffB); PG8_STAGE(PG8_SA(0, 0), cA, voffA); PG8_STAGE(PG8_SA(0, 1), cA + hstep, voffA);
        if (wr == 1) PG8_BAR;
        PG8_WAIT_V(2); PG8_BAR;
        PG8_STAGE(PG8_SB(1, 0), cB + kstep, voffB); PG8_STAGE(PG8_SA(1, 0), cA + kstep, voffA); PG8_STAGE(PG8_SB(1, 1), cB + hstep + kstep, voffB);
        PG8_WAIT_V(6); PG8_BAR;
    } else {
        PG8_STAGE(PG8_SB(0, 0), cB, voffB); PG8_STAGE(PG8_SA(0, 0), cA, voffA); PG8_STAGE(PG8_SB(0, 1), cB + hstep, voffB); PG8_STAGE(PG8_SA(0, 1), cA + hstep, voffA);
        if (wr == 1) PG8_BAR;
        PG8_WAIT_V(4); PG8_BAR;
        PG8_STAGE(PG8_SB(1, 0), cB + kstep, voffB); PG8_STAGE(PG8_SA(1, 0), cA + kstep, voffA); PG8_STAGE(PG8_SB(1, 1), cB + hstep + kstep, voffB);
        PG8_WAIT_V(6); PG8_BAR;
    }
    for (;;) {
        const bool has_next = S.next(ui + 1, nxt);
        const char* nA = has_next ? (const char*)g.A + (size_t)nxt.pm * tstep : cA; const char* nB = has_next ? (const char*)g.Bt + (size_t)nxt.pn * tstep : cB;
        for (int t = 0; t < nt; t += 2) {
            const bool last = (t == nt - 2);
            const char* a1 = cA + (size_t)(t + 1) * kstep;
            const char* a2 = last ? nA : cA + (size_t)(t + 2) * kstep; const char* b2 = last ? nB : cB + (size_t)(t + 2) * kstep;
            const char* a3 = a2 + kstep; const char* b3 = b2 + kstep;
            if (last && has_next) S.a_ready(nxt);
            if constexpr (SP2) {
            PG8_LDB(B0, 0, 0); PG8_LDB(B1, 0, 1); PG8_SCHED; PG8_LDA(At, 0, 0); PG8_STAGE(PG8_SA(1, 1), a1 + hstep, voffA);
            PG8_WAIT_V(8); PG8_WAIT_L(0); PG8_BAR; PG8_MMA(0, 0, At, B0); PG8_MMA(0, 1, At, B1); PG8_BAR; PG8_SCHED;
            PG8_LDA(At, 0, 1); PG8_STAGE(PG8_SB(0, 0), b2, voffB); PG8_STAGE(PG8_SB(0, 1), b2 + hstep, voffB); PG8_STAGE(PG8_SA(0, 0), a2, voffA);
            PG8_WAIT_V(8); PG8_WAIT_L(0); PG8_BAR; PG8_MMA(1, 0, At, B0); PG8_MMA(1, 1, At, B1); PG8_BAR; PG8_SCHED;
            PG8_LDB(B0, 1, 0); PG8_LDB(B1, 1, 1); PG8_SCHED; PG8_LDA(At, 1, 0); PG8_STAGE(PG8_SA(0, 1), a2 + hstep, voffA);
            PG8_WAIT_V(8); PG8_WAIT_L(0); PG8_BAR; PG8_MMA(0, 0, At, B0); PG8_MMA(0, 1, At, B1); PG8_BAR; PG8_SCHED;
            PG8_LDA(At, 1, 1); PG8_STAGE(PG8_SB(1, 0), b3, voffB); PG8_STAGE(PG8_SB(1, 1), b3 + hstep, voffB); PG8_STAGE(PG8_SA(1, 0), a3, voffA);
            PG8_WAIT_V(8); PG8_WAIT_L(0); PG8_BAR; PG8_MMA(1, 0, At, B0); PG8_MMA(1, 1, At, B1); PG8_BAR; PG8_SCHED;
            } else {
            PG8_LDB(B0, 0, 0); PG8_SCHED; PG8_LDA(At, 0, 0); PG8_STAGE(PG8_SA(1, 1), a1 + hstep, voffA);
            PG8_WAIT_L(8); PG8_BAR; PG8_WAIT_L(0); PG8_MMA(0, 0, At, B0); PG8_BAR; PG8_SCHED;
            PG8_LDB(B1, 0, 1); PG8_STAGE(PG8_SB(0, 0), b2, voffB);
            PG8_BAR; PG8_WAIT_L(0); PG8_MMA(0, 1, At, B1); PG8_BAR;
            PG8_LDA(At, 0, 1); PG8_STAGE(PG8_SA(0, 0), a2, voffA);
            PG8_BAR; PG8_WAIT_L(0); PG8_MMA(1, 0, At, B0); PG8_BAR; PG8_SCHED;
            PG8_STAGE(PG8_SB(0, 1), b2 + hstep, voffB);
            PG8_WAIT_V(6); PG8_BAR; PG8_MMA(1, 1, At, B1); PG8_BAR;
            PG8_LDB(B0, 1, 0); PG8_SCHED; PG8_LDA(At, 1, 0); PG8_STAGE(PG8_SA(0, 1), a2 + hstep, voffA);
            PG8_WAIT_L(8); PG8_BAR; PG8_WAIT_L(0); PG8_MMA(0, 0, At, B0); PG8_BAR; PG8_SCHED;
            PG8_LDB(B1, 1, 1); PG8_STAGE(PG8_SB(1, 0), b3, voffB);
            PG8_BAR; PG8_WAIT_L(0); PG8_MMA(0, 1, At, B1); PG8_BAR;
            PG8_LDA(At, 1, 1); PG8_STAGE(PG8_SA(1, 0), a3, voffA);
            PG8_BAR; PG8_WAIT_L(0); PG8_MMA(1, 0, At, B0); PG8_BAR; PG8_SCHED;
            PG8_STAGE(PG8_SB(1, 1), b3 + hstep, voffB);
            PG8_WAIT_V(6); PG8_BAR; PG8_MMA(1, 1, At, B1); PG8_BAR;
            }
        }
        if constexpr (ALIGN_EPI) { if (wr == 0) PG8_BAR; }
        if constexpr (!Epi::AFTER_DRAIN) { E(acc, cur, wr, wc, fr, fq); S.done(cur); }
        if (!has_next) break;
#pragma unroll
        for (int a = 0; a < 2; ++a)
#pragma unroll
            for (int b = 0; b < 2; ++b)
#pragma unroll
                for (int m = 0; m < 4; ++m)
#pragma unroll
                    for (int n = 0; n < 2; ++n) acc[a][b][m][n] = (f32x4){0.f, 0.f, 0.f, 0.f};
        cur = nxt; cA = nA; cB = nB; ++ui;
        if constexpr (ALIGN_EPI) { if (wr == 1) PG8_BAR; }
    }
    PG8_WAIT_V(0);
    if constexpr (!ALIGN_EPI) { if (wr == 0) PG8_BAR; }
    PG8_BAR;
    if constexpr (Epi::AFTER_DRAIN) { E.fused(acc, cur, wr, wc, fr, fq, lds, wid, lane); S.done(cur); }
#undef PG8_SA
#undef PG8_SB
#undef PG8_STAGE
#undef PG8_LDA
#undef PG8_LDB
#undef PG8_MMA
#undef PG8_WAIT_V
#undef PG8_WAIT_L
#undef PG8_BAR
#undef PG8_SCHED
}
}

constexpr int EPI8_OFF = 131072, EPI8_IMG = 2304;
DI int logical_col(int n) { return (n & ~255) | (((n >> 5) & 3) << 6) | (((n >> 7) & 1) << 5) | (n & 31); }
DI void store16x64_bf16(char* img, bf16_t* dst, size_t ld, const f32x4 (&v)[2][2], int fr, int fq, float sc) {
  char* wp = img + fr * 144 + fq * 8;
#pragma unroll
  for (int bj = 0; bj < 2; ++bj)
#pragma unroll
    for (int n = 0; n < 2; ++n) { u32x2 w = {pk2(v[bj][n][0] * sc, v[bj][n][1] * sc), pk2(v[bj][n][2] * sc, v[bj][n][3] * sc)}; *(u32x2*)(wp + bj * 64 + n * 32) = w; }
  asm volatile("" ::: "memory");
  const int lane = fq * 16 + fr, rr = lane >> 2, pc = (lane & 3) * 2;
#pragma unroll
  for (int k = 0; k < 2; ++k) { const u32x4 d = *(const u32x4*)(img + rr * 144 + (pc + k) * 16); *(u32x4*)(dst + (size_t)rr * ld + (pc + k) * 8) = d; }
  asm volatile("" ::: "memory");
}
DI void rope_grp(f32x4& lo, f32x4& hi, const float* __restrict__ rope, int pos, int fq) {
  const float* t = rope + (size_t)pos * 32 + 8 * fq;
  const f32x4 c0 = *(const f32x4*)t, c1 = *(const f32x4*)(t + 4);
  float x1, x2;
  x1 = lo[0]; x2 = hi[0]; lo[0] = x1 * c0[0] - x2 * c0[1]; hi[0] = x2 * c0[0] + x1 * c0[1];
  x1 = lo[1]; x2 = hi[1]; lo[1] = x1 * c0[2] - x2 * c0[3]; hi[1] = x2 * c0[2] + x1 * c0[3];
  x1 = lo[2]; x2 = hi[2]; lo[2] = x1 * c1[0] - x2 * c1[1]; hi[2] = x2 * c1[0] + x1 * c1[1];
  x1 = lo[3]; x2 = hi[3]; lo[3] = x1 * c1[2] - x2 * c1[3]; hi[3] = x2 * c1[2] + x1 * c1[3];
}
DI float ssq4(const f32x4& a) { return (a[0] * a[0] + a[1] * a[1]) + (a[2] * a[2] + a[3] * a[3]); }

struct EpiInProj8 {
  static constexpr bool PERM = false, AFTER_DRAIN = false;
  const Params* pp; int layer; char* img0;
  DI void operator()(const pg8::f32x4 (&acc)[2][2][4][2], const pg8::Unit& u, int wr, int wc, int fr, int fq) const {
    asm volatile("" : "+v"(fr), "+v"(fq));
    const Params& p = *pp;
    const int hu = u.pn * 4 + wc;
    if (hu == 43) return;
    char* img = img0 + (wr * 4 + wc) * EPI8_IMG;
    const int bb = (u.pm * 256) >> 12;
#pragma unroll
    for (int ai = 0; ai < 2; ++ai) {
      float nm0 = 0.f, nm1 = 0.f;
#pragma unroll
      for (int m = 0; m < 4; ++m) {
        __builtin_amdgcn_sched_barrier(0);
        const int token = u.pm * 256 + 128 * ai + 64 * wr + 16 * m + fr, s = token & 4095;
        f32x4 v[2][2];
#pragma unroll
        for (int bj = 0; bj < 2; ++bj)
#pragma unroll
          for (int n = 0; n < 2; ++n) v[bj][n] = acc[ai][bj][m][n];
        if (hu == 28 || hu == 29) {
#pragma unroll
          for (int bj = 0; bj < 2; ++bj)
#pragma unroll
            for (int n = 0; n < 2; ++n)
#pragma unroll
              for (int e = 0; e < 4; ++e) { const int d = 32 * bj + 16 * n + 4 * fq + e;
                p.vtc[((size_t)((bb * 2 + hu - 28) * 64 + d)) * 4096 + s] = (bf16_t)(pk2(v[bj][n][e], 0.f) & 0xffffu); }
          continue;
        }
        float sc = 1.f;
        if (hu < 4) sc = SC_A;
        if (hu < 8) {
          float n0 = ssq4(v[0][0]) + ssq4(v[0][1]), n1 = ssq4(v[1][0]) + ssq4(v[1][1]);
          n0 += __shfl_xor(n0, 16); n0 += __shfl_xor(n0, 32); n1 += __shfl_xor(n1, 16); n1 += __shfl_xor(n1, 32);
          nm0 = fmaxf(nm0, n0); nm1 = fmaxf(nm1, n1);
        } else if (hu >= 12 && hu < 22) {
          float q = (ssq4(v[0][0]) + ssq4(v[0][1])) + (ssq4(v[1][0]) + ssq4(v[1][1]));
          q += __shfl_xor(q, 16); q += __shfl_xor(q, 32);
          if (fq == 0) p.ssq[(size_t)token * 16 + (hu - 12)] = q;
        } else if (hu >= 22 && hu < 28) {
          float q = (ssq4(v[0][0]) + ssq4(v[0][1])) + (ssq4(v[1][0]) + ssq4(v[1][1]));
          q += __shfl_xor(q, 16); q += __shfl_xor(q, 32);
          const float rinv = rsqrtf(q * (1.f / 64.f) + 1e-6f);
          const float* g = (hu < 26 ? p.gqa_q_norm_g : p.gqa_k_norm_g) + layer * 64 + 4 * fq;
#pragma unroll
          for (int bj = 0; bj < 2; ++bj)
#pragma unroll
            for (int n = 0; n < 2; ++n) v[bj][n] = v[bj][n] * rinv * *(const f32x4*)(g + 32 * bj + 16 * n);
          rope_grp(v[0][0], v[0][1], p.rope, s >> 6, fq); rope_grp(v[1][0], v[1][1], p.rope, s & 63, fq);
          if (hu < 26) sc = SC_C;
        } else if (hu >= 30 && hu < 34) sc = SC_C;
        else if (hu == 42) rope_grp(v[0][0], v[0][1], p.rope, s, fq);
        store16x64_bf16(img, p.proj + (size_t)(token - fr) * LDP + hu * 64, LDP, v, fr, fq, sc);
      }
      if (hu < 8) {
#pragma unroll
        for (int o = 8; o > 0; o >>= 1) { nm0 = fmaxf(nm0, __shfl_xor(nm0, o)); nm1 = fmaxf(nm1, __shfl_xor(nm1, o)); }
        if (fr == 0 && fq == 0) {
          const int s0 = (u.pm * 256 + 128 * ai + 64 * wr) & 4095;
          if (hu < 4) { const int idx = 4096 + ((bb * 4 + hu) * 2) * 32 + (s0 >> 7);
            atomicMax(p.nmax + idx, __float_as_uint(nm0 * SC_A * SC_A)); atomicMax(p.nmax + idx + 32, __float_as_uint(nm1 * SC_A * SC_A)); }
          else { const int idx = ((bb * 4 + hu - 4) * 2) * 64 + (s0 >> 6);
            atomicMax(p.nmax + idx, __float_as_uint(nm0)); atomicMax(p.nmax + idx + 64, __float_as_uint(nm1)); }
        }
      }
    }
  }
};
struct EpiVt8 {
  static constexpr bool PERM = false, AFTER_DRAIN = false;
  bf16_t* vt;
  DI void operator()(const pg8::f32x4 (&acc)[2][2][4][2], const pg8::Unit& u, int wr, int wc, int fr, int fq) const {
    const int bb = (u.pm * 256) >> 12;
#pragma unroll
    for (int ai = 0; ai < 2; ++ai)
#pragma unroll
      for (int m = 0; m < 4; ++m) { const int s = (u.pm * 256 + 128 * ai + 64 * wr + 16 * m + 4 * fq) & 4095;
#pragma unroll
        for (int bj = 0; bj < 2; ++bj)
#pragma unroll
          for (int n = 0; n < 2; ++n) { const int d = 32 * bj + 16 * n + fr; const pg8::f32x4 a = acc[ai][bj][m][n];
            st4(vt + ((size_t)((bb * 4 + wc) * 64 + d)) * 4096 + s, a[0], a[1], a[2], a[3]); } }
  }
};
struct EpiUp8 {
  static constexpr bool PERM = false, AFTER_DRAIN = false;
  bf16_t* U; char* img0;
  DI void operator()(const pg8::f32x4 (&acc)[2][2][4][2], const pg8::Unit& u, int wr, int wc, int fr, int fq) const {
    char* img = img0 + (wr * 4 + wc) * EPI8_IMG;
#pragma unroll
    for (int ai = 0; ai < 2; ++ai)
#pragma unroll
      for (int m = 0; m < 4; ++m) {
        f32x4 v[2][2];
#pragma unroll
        for (int bj = 0; bj < 2; ++bj)
#pragma unroll
          for (int n = 0; n < 2; ++n) { const pg8::f32x4 a = acc[ai][bj][m][n];
#pragma unroll
            for (int e = 0; e < 4; ++e) { const float t = fmaxf(a[e], 0.f); v[bj][n][e] = t * t; } }
        store16x64_bf16(img, U + (size_t)(u.pm * 256 + 128 * ai + 64 * wr + 16 * m) * 4096 + u.pn * 256 + wc * 64, 4096, v, fr, fq, 1.f);
      }
  }
};
struct EpiResid8 {
  static constexpr bool PERM = false, AFTER_DRAIN = false;
  const float* xsrc; float* out; const float* gate; const float* stat; const float* lng; const float* lnb; char* img0;
  DI void operator()(const pg8::f32x4 (&acc)[2][2][4][2], const pg8::Unit& u, int wr, int wc, int fr, int fq) const {
    char* img = img0 + (wr * 4 + wc) * EPI8_IMG;
    const int lane = fq * 16 + fr, rr = lane >> 2, pc = (lane & 3) * 2, bb = (u.pm * 256) >> 12;
#pragma unroll
    for (int bj = 0; bj < 2; ++bj) {
      const int col = u.pn * 256 + wc * 64 + 32 * bj + pc * 4;
      const f32x4 gt0 = *(const f32x4*)(gate + bb * 6144 + col), gt1 = *(const f32x4*)(gate + bb * 6144 + col + 4);
      f32x4 lg0 = {1.f, 1.f, 1.f, 1.f}, lg1 = lg0, lb0 = {0.f, 0.f, 0.f, 0.f}, lb1 = lb0;
      if (stat) { lg0 = *(const f32x4*)(lng + col); lg1 = *(const f32x4*)(lng + col + 4); lb0 = *(const f32x4*)(lnb + col); lb1 = *(const f32x4*)(lnb + col + 4); }
#pragma unroll
      for (int ai = 0; ai < 2; ++ai)
#pragma unroll
      for (int mh = 0; mh < 2; ++mh) {
        f32x4 xa[2][2]; f32x2 ms[2];
#pragma unroll
        for (int k = 0; k < 2; ++k) {
          const int row = u.pm * 256 + 128 * ai + 64 * wr + 16 * (2 * mh + k) + rr;
          const size_t off = (size_t)row * DM + col;
          xa[k][0] = *(const f32x4*)(xsrc + off); xa[k][1] = *(const f32x4*)(xsrc + off + 4);
          ms[k] = stat ? *(const f32x2*)(stat + (size_t)row * 2) : (f32x2){0.f, 1.f};
        }
#pragma unroll
        for (int k = 0; k < 2; ++k) {
          const int m = 2 * mh + k;
          *(f32x4*)(img + fr * 144 + fq * 16) = acc[ai][bj][m][0]; *(f32x4*)(img + fr * 144 + 64 + fq * 16) = acc[ai][bj][m][1];
          asm volatile("" ::: "memory");
          const f32x4 a0 = *(const f32x4*)(img + rr * 144 + pc * 16), a1 = *(const f32x4*)(img + rr * 144 + pc * 16 + 16);
          const int row = u.pm * 256 + 128 * ai + 64 * wr + 16 * m + rr;
          const size_t off = (size_t)row * DM + col;
          f32x4 x0 = xa[k][0], x1 = xa[k][1];
          if (stat) { x0 = (x0 - ms[k][0]) * ms[k][1] * lg0 + lb0; x1 = (x1 - ms[k][0]) * ms[k][1] * lg1 + lb1; }
          *(f32x4*)(out + off) = ALPHA * x0 + gt0 * a0; *(f32x4*)(out + off + 4) = ALPHA * x1 + gt1 * a1;
          asm volatile("" ::: "memory");
        }
      }
    }
  }
};
struct SkipOrder { pg8::StaticOrder S;
  __device__ bool next(int i, pg8::Unit& u) const { if (!S.next(i, u)) return false; if (u.pn >= 2) u.pn += 1; return true; }
  __device__ __forceinline__ void a_ready(const pg8::Unit&) const {} __device__ __forceinline__ void done(const pg8::Unit&) const {} };
struct ColOrder { int pn, first, G;
  __device__ bool next(int i, pg8::Unit& u) const { const int t = first + i * G; if (t >= 128) return false; u.pm = t; u.pn = pn; return true; }
  __device__ __forceinline__ void a_ready(const pg8::Unit&) const {} __device__ __forceinline__ void done(const pg8::Unit&) const {} };

DI int colmap(int kind, int n) {
  if (kind == 0 || kind == 3) n = logical_col(n);
  if (kind == 0) { if (n < 1408) return n; if (n < 2688) return n + 32; if (n < 2720) return n - 2688 + 1408; return -1; }
  if (kind == 1) { if (n >= 384) return -1; if (n < 256) return (n >> 6) * 96 + (n & 63); const int mm = n - 256; return (mm >> 5) * 96 + 64 + (mm & 31); }
  if (kind == 2) { if (n < 256) return (n >> 6) * 128 + (n & 63); const int mm = n - 256; return (mm >> 6) * 128 + 64 + (mm & 63); }
  return n;
}
DI void transpose_tile(char* lds, const float* __restrict__ in, int ldin, const float* __restrict__ scale, bf16_t* __restrict__ out, int Kdim, int kind, int nt, int kt) {
  float* tile = (float*)lds;
  const int tid = tidx(), n0 = nt * 64, k0 = kt * 64;
  {
    const int nl = (tid & 15) * 4, col = colmap(kind, n0 + nl);
#pragma unroll
    for (int rr = 0; rr < 2; ++rr) { const int kl = rr * 32 + (tid >> 4);
      f32x4 v = {0.f, 0.f, 0.f, 0.f}; if (col >= 0) { v = *(const f32x4*)(in + (size_t)(k0 + kl) * ldin + col); if (scale) v *= scale[k0 + kl]; }
      float* t = tile + kl * 65 + nl; t[0] = v[0]; t[1] = v[1]; t[2] = v[2]; t[3] = v[3]; }
  }
  __syncthreads();
  {
    const int nl = tid >> 3, kc = (tid & 7) * 8;
    float v[8];
#pragma unroll
    for (int e = 0; e < 8; ++e) v[e] = tile[(kc + e) * 65 + nl];
    bf16_t* dst = out + (size_t)(n0 + nl) * Kdim + k0 + kc;
    u32x4 w0 = {pk2(v[0], v[1]), pk2(v[2], v[3]), pk2(v[4], v[5]), pk2(v[6], v[7])};
    *(u32x4*)dst = w0;
  }
  __syncthreads();
}

constexpr int TR_PER_LAYER = 704 + 256 + 1024 + 1024 + 48 + 32;
DI void phase_prologue_a(char* lds, const Params& p, int bid, int nb) {
  const int total = 2 * TR_PER_LAYER + 192 + 128;
  for (int u = bid; u < total; u += nb) {
    if (u < 2 * TR_PER_LAYER) {
      const int l = u / TR_PER_LAYER; int r = u % TR_PER_LAYER;
      if (r < 704) { transpose_tile(lds, p.w_in + (size_t)l * 1024 * 2720, 2720, nullptr, p.wt_in + (size_t)l * 2816 * 1024, 1024, 0, r >> 4, r & 15); continue; } r -= 704;
      if (r < 256) { transpose_tile(lds, p.w_o + (size_t)l * 1024 * 1024, 1024, nullptr, p.wt_o + (size_t)l * 1024 * 1024, 1024, 3, r >> 4, r & 15); continue; } r -= 256;
      if (r < 1024) { transpose_tile(lds, p.w_up + (size_t)l * 1024 * 4096, 4096, nullptr, p.wt_up + (size_t)l * 4096 * 1024, 1024, 3, r >> 4, r & 15); continue; } r -= 1024;
      if (r < 1024) { transpose_tile(lds, p.w_down + (size_t)l * 4096 * 1024, 1024, nullptr, p.wt_down + (size_t)l * 1024 * 4096, 4096, 3, r >> 6, r & 63); continue; } r -= 1024;
      if (r < 48) { transpose_tile(lds, p.mla_w_uq + (size_t)l * 384 * 384, 384, p.mla_q_norm_g + l * 384, p.wt_uq + (size_t)l * 512 * 384, 384, 1, r / 6, r % 6); continue; } r -= 48;
      transpose_tile(lds, p.mla_w_ukv + (size_t)l * 256 * 512, 512, p.mla_kv_norm_g + l * 256, p.wt_ukv + (size_t)l * 512 * 256, 256, 2, r >> 2, r & 3);
    } else if (u < 2 * TR_PER_LAYER + 192) {
      const int r = u - 2 * TR_PER_LAYER, kc = r & 7, jb = (r >> 3) % 12, l = r / 96;
      float* sl = (float*)lds;
#pragma unroll
      for (int e = 0; e < 2; ++e) { const int i = tidx() + 512 * e, bb = i >> 7, k = i & 127; const float cv = p.c[bb * 1024 + kc * 128 + k]; sl[i] = cv / (1.f + expf(-cv)); }
      __syncthreads();
      const int j = jb * 512 + tidx();
      float a0 = 0.f, a1 = 0.f, a2 = 0.f, a3 = 0.f, a4 = 0.f, a5 = 0.f, a6 = 0.f, a7 = 0.f;
      const float* w = p.w_ada + ((size_t)l * 1024 + kc * 128) * 6144 + j;
#pragma unroll 4
      for (int k = 0; k < 128; ++k) { const float wv = w[(size_t)k * 6144];
        a0 += sl[k] * wv; a1 += sl[128 + k] * wv; a2 += sl[256 + k] * wv; a3 += sl[384 + k] * wv; a4 += sl[512 + k] * wv; a5 += sl[640 + k] * wv; a6 += sl[768 + k] * wv; a7 += sl[896 + k] * wv; }
      float* d = p.modp + ((size_t)(kc * 2 + l) * 8) * 6144 + j;
      d[0] = a0; d[6144] = a1; d[2 * 6144] = a2; d[3 * 6144] = a3; d[4 * 6144] = a4; d[5 * 6144] = a5; d[6 * 6144] = a6; d[7 * 6144] = a7;
      __syncthreads();
    } else {
      const int idx = (u - 2 * TR_PER_LAYER - 192) * 512 + tidx(), pos = idx >> 4, i = idx & 15;
      double fr = 1.0; for (int k = 0; k < i; ++k) fr *= 0.56234132519034908;
      const float ang = (float)pos * (float)fr;
      double a = (double)ang; a -= 6.283185307179586476925 * __builtin_rint(a * 0.15915494309189533577);
      const double tq = a * 0.125, t2 = tq * tq;
      double sn = tq * (1.0 + t2 * (-1.0 / 6 + t2 * (1.0 / 120 + t2 * (-1.0 / 5040 + t2 * (1.0 / 362880 + t2 * (-1.0 / 39916800 + t2 * (1.0 / 6227020800.0)))))));
      double cs = 1.0 + t2 * (-0.5 + t2 * (1.0 / 24 + t2 * (-1.0 / 720 + t2 * (1.0 / 40320 + t2 * (-1.0 / 3628800 + t2 * (1.0 / 479001600.0 + t2 * (-1.0 / 87178291200.0)))))));
#pragma unroll
      for (int k = 0; k < 3; ++k) { const double s2 = 2.0 * sn * cs, c2 = cs * cs - sn * sn; sn = s2; cs = c2; }
      p.rope[(size_t)idx * 2] = (float)cs; p.rope[(size_t)idx * 2 + 1] = (float)sn;
    }
  }
}
DI void phase_prologue_b(const Params& p, int bid, int nb) {
  const int tid = tidx(), lane = tid & 63, wid = tid >> 6;
  if (bid == 0) for (int i = tid; i < 6144 + 64; i += 512) p.nmax[i] = 0u;
  for (int u = bid; u < 512 + 192; u += nb) {
    if (u < 512) {
      const int row0 = u * 64, b = row0 >> 12;
      f32x4 sh[4], sc[4];
#pragma unroll
      for (int e = 0; e < 4; ++e) { const int col = e * 256 + lane * 4;
        f32x4 a = *(const f32x4*)(p.b_ada + col), c = *(const f32x4*)(p.b_ada + 1024 + col);
        for (int kc = 0; kc < 8; ++kc) { const float* mp = p.modp + ((size_t)(kc * 2 + 0) * 8 + b) * 6144; a += *(const f32x4*)(mp + col); c += *(const f32x4*)(mp + 1024 + col); }
        sh[e] = a; sc[e] = c + 1.f; }
      for (int r = wid; r < 64; r += 8) { const size_t row = (size_t)(row0 + r);
#pragma unroll
        for (int e = 0; e < 4; ++e) { const int col = e * 256 + lane * 4; const f32x4 xv = *(const f32x4*)(p.x + row * DM + col); const f32x4 hv = xv * sc[e] + sh[e];
          st4(p.H + row * DM + col, hv[0], hv[1], hv[2], hv[3]); } }
    } else {
      const int idx = (u - 512) * 512 + tid, j = idx % 6144, lb = idx / 6144, l = lb >> 3, b = lb & 7;
      float a = p.b_ada[l * 6144 + j];
      for (int kc = 0; kc < 8; ++kc) a += p.modp[((size_t)(kc * 2 + l) * 8 + b) * 6144 + j];
      p.mod[(size_t)lb * 6144 + j] = a;
    }
  }
}
DI void phase_ln(const Params& p, const float* g, const float* bta, const float* sh, const float* sc, bool writex, int bid, int nb) {
  const int tid = tidx(), lane = tid & 63, wid = tid >> 6;
  for (int row = bid * 8 + wid; row < NTOK; row += nb * 8) {
    float* xr = p.out + (size_t)row * DM; const int b = row >> 12;
    f32x4 v[4]; float s = 0.f;
#pragma unroll
    for (int e = 0; e < 4; ++e) { v[e] = *(const f32x4*)(xr + e * 256 + lane * 4); s += (v[e][0] + v[e][1]) + (v[e][2] + v[e][3]); }
#pragma unroll
    for (int o = 32; o > 0; o >>= 1) s += __shfl_xor(s, o);
    const float mu = s * (1.f / 1024.f); float q = 0.f;
#pragma unroll
    for (int e = 0; e < 4; ++e) { v[e] -= mu; q += (v[e][0] * v[e][0] + v[e][1] * v[e][1]) + (v[e][2] * v[e][2] + v[e][3] * v[e][3]); }
#pragma unroll
    for (int o = 32; o > 0; o >>= 1) q += __shfl_xor(q, o);
    const float rstd = rsqrtf(q * (1.f / 1024.f) + 1e-5f);
    if (!writex && lane == 0) { f32x2 ms = {mu, rstd}; *(f32x2*)(p.lnstat + (size_t)row * 2) = ms; }
#pragma unroll
    for (int e = 0; e < 4; ++e) { const int col = e * 256 + lane * 4;
      const f32x4 y = v[e] * rstd * *(const f32x4*)(g + col) + *(const f32x4*)(bta + col);
      if (writex) *(f32x4*)(xr + col) = y;
      if (sh) { const f32x4 hv = y * (*(const f32x4*)(sc + b * 6144 + col) + 1.f) + *(const f32x4*)(sh + b * 6144 + col); st4(p.H + (size_t)row * DM + col, hv[0], hv[1], hv[2], hv[3]); } }
  }
}

#define XB_TMO      128
#define XB_XCNT(j)  (256  + 64 * (j))
#define XB_XSUB(j)  (1280 + 64 * (j))
#define XB_XGEN(j)  (2304 + 64 * (j))
#define XB_TOP      3328
#define XB_TOPGEN   3392
#define XCD_BAR_WORDS 3456
#define XB_SPIN_CAP (1u << 18)

__device__ __forceinline__ unsigned xb_ld(unsigned* p)              { return __hip_atomic_load(p, __ATOMIC_RELAXED, __HIP_MEMORY_SCOPE_AGENT); }
__device__ __forceinline__ unsigned xb_add(unsigned* p, unsigned v) { return __hip_atomic_fetch_add(p, v, __ATOMIC_RELAXED, __HIP_MEMORY_SCOPE_AGENT); }
__device__ __forceinline__ unsigned xb_xcc_id() { return (unsigned)__builtin_amdgcn_s_getreg((3 << 11) | 20) & 0xFu; }
#define XB_SPIN(cond, bar) do { unsigned _sp = 0; while (cond) { __builtin_amdgcn_s_sleep(1); \
    if ((++_sp & 255u) == 0u) { if (xb_ld(&(bar)[XB_TMO])) break; if (_sp > XB_SPIN_CAP) { atomicAdd(&(bar)[XB_TMO], 1u); break; } } } } while (0)

struct XcdBarrier {
    unsigned* bar; unsigned x;
    volatile LAS unsigned* st;
};

__device__ __forceinline__ XcdBarrier xcd_barrier_post(unsigned* bar, volatile LAS unsigned* st) {
    XcdBarrier b; b.bar = bar; b.x = xb_xcc_id(); b.st = st;
    if (threadIdx.x == 0) (void)xb_add(&bar[XB_XCNT(b.x)], 1u);
    return b;
}
__device__ __forceinline__ void xcd_barrier_complete(unsigned* bar, unsigned x, unsigned& nloc, unsigned& nx) {
    const unsigned G = gridDim.x * gridDim.y * gridDim.z;
    unsigned sum, cnt, mine, sp = 0u;
    for (;;) {
        sum = 0u; cnt = 0u; mine = 0u;
#pragma unroll
        for (unsigned j = 0; j < 16; ++j) { const unsigned c = xb_ld(&bar[XB_XCNT(j)]); sum += c; cnt += (c > 0u) ? 1u : 0u; mine = (j == x) ? c : mine; }
        if (sum == G) break;
        __builtin_amdgcn_s_sleep(1);
        if ((++sp & 255u) == 0u) { if (xb_ld(&bar[XB_TMO])) break; if (sp > XB_SPIN_CAP) { atomicAdd(&bar[XB_TMO], 1u); break; } }
    }
    nloc = mine > 0u ? mine : 1u; nx = cnt > 0u ? cnt : 1u;
}

__device__ __forceinline__ void xcd_barrier(const XcdBarrier& b) {
    asm volatile("s_waitcnt vmcnt(0)" ::: "memory");
    __syncthreads();
    if (threadIdx.x == 0) {
        unsigned* bar = b.bar;
        __builtin_amdgcn_s_waitcnt(0);
        unsigned nloc = b.st[0], nx = b.st[1];
        if (nloc == 0u) { xcd_barrier_complete(bar, b.x, nloc, nx); b.st[0] = nloc; b.st[1] = nx; }
        const unsigned old = xb_add(&bar[XB_XSUB(b.x)], 1u);
        const unsigned gen = old / nloc;
        if (old + 1u == (gen + 1u) * nloc) {
            __builtin_amdgcn_fence(__ATOMIC_RELEASE, "agent");
            asm volatile("s_waitcnt vmcnt(0)" ::: "memory");
            const unsigned og = xb_add(&bar[XB_TOP], 1u);
            const unsigned tg = og / nx;
            if (og + 1u == (tg + 1u) * nx) xb_add(&bar[XB_TOPGEN], 1u);
            else XB_SPIN(xb_ld(&bar[XB_TOPGEN]) == tg, bar);
            __builtin_amdgcn_fence(__ATOMIC_ACQUIRE, "agent");
            xb_add(&bar[XB_XGEN(b.x)], 1u);
            asm volatile("s_waitcnt vmcnt(0)" ::: "memory");
        } else {
            XB_SPIN(xb_ld(&bar[XB_XGEN(b.x)]) == gen, bar);
            __builtin_amdgcn_fence(__ATOMIC_ACQUIRE, "agent");
            asm volatile("s_waitcnt vmcnt(0)" ::: "memory");
        }
    }
    __syncthreads();
}


constexpr int NPHASE = 2 + 8 * 2;
DI void run_phase(const Params& p, int ph, char* lds, int bid, int nb) {
  if (ph == 0) { phase_prologue_a(lds, p, bid, nb); return; }
  if (ph == 1) { phase_prologue_b(p, bid, nb); return; }
  const int l = (ph - 2) >> 3, sp = (ph - 2) & 7;
  const float* mod = p.mod + (size_t)l * 8 * 6144;
  if (sp == 0) {
    const bf16_t* W = p.wt_in + (size_t)l * 2816 * 1024;
    const pg8::Gemm g{p.H, W, NTOK, 2816, 1024};
    __syncthreads();
    { EpiInProj8 e8{&p, l, lds + EPI8_OFF}; SkipOrder so; so.S.init(NTOK, 2560, nb, bid);
      pg8::gemm_phase<EpiInProj8, SkipOrder, true, true, false>((PG8_LAS unsigned char*)lds, g, so, e8); }
    __syncthreads();
    { EpiVt8 ev{p.vta}; const ColOrder co{2, (nb == 256 ? (bid >= 128 ? bid - 128 : bid + 128) : bid), nb};
      pg8::gemm_phase<EpiVt8, ColOrder, true, true, true>((PG8_LAS unsigned char*)lds, g, co, ev); }
    __syncthreads();
  } else if (sp == 1) {
    EpiMla<0> eq{p}; EpiMla<1> ekv{p};
    gemm_loop<false>(lds, p.proj + C_BCQ, LDP, p.wt_uq + (size_t)l * 512 * 384, 384, 384, bid, nb, 256, 2, 0, eq);
#if PROBE_DUP == 6
    gemm_loop<false>(lds, p.proj + C_BCQ, LDP, p.wt_uq + (size_t)l * 512 * 384, 384, 384, bid, nb, 256, 2, 0, eq);
#endif
    gemm_loop<false>(lds, p.proj + C_BCKV, LDP, p.wt_ukv + (size_t)l * 512 * 256, 256, 256, bid, nb, 128, 1, 0, ekv);
    gemm_loop<true>(lds, p.proj + C_BCKV, LDP, p.wt_ukv + (size_t)l * 512 * 256, 256, 256, (nb == 256 ? (bid >= 128 ? bid - 128 : bid + 128) : bid), nb, 128, 1, 1, ekv);
    for (int t = bid; t < 1536; t += nb) attn_d6_unit(lds, p, l, t);
#if PROBE_DUP == 5
    for (int t = bid; t < 1536; t += nb) attn_d6_unit(lds, p, l, t);
#endif
  } else if (sp == 2) {
    int* su = (int*)(lds + LDS_BYTES - 16);
    __syncthreads();
    if (tidx() == 0) *su = (int)atomicAdd(p.nmax + 6144 + l, 1u);
    __syncthreads();
    int q = *su;
    while (q < 2048 + 1024) {
      int qn = 0;
      if (tidx() == 0) qn = (int)atomicAdd(p.nmax + 6144 + l, 1u);
      if (q >= 2048) dcombine_unit(p, q - 2048);
      else if (q < 256 || q >= 1280) attn_unit<0>(lds, p, l, q < 256 ? 768 + q : 2047 - q);
      else if (q < 768) attn_unit<1>(lds, p, l, q - 256);
      else attn_unit<2>(lds, p, l, q - 768);
      __syncthreads();
      if (tidx() == 0) *su = qn;
      __syncthreads();
      q = *su;
    }
  } else if (sp == 3) {
    const EpiResid8 epi{l == 0 ? p.x : p.out, p.out, mod + 2 * 1024, l == 0 ? nullptr : p.lnstat, p.ln_mlp_g + (l - (l > 0)) * 1024, p.ln_mlp_b + (l - (l > 0)) * 1024, lds + EPI8_OFF};
    const pg8::Gemm g{p.Y, p.wt_o + (size_t)l * 1024 * 1024, NTOK, 1024, 1024};
    pg8::StaticOrder S; S.init(NTOK, 1024, nb, bid);
    __syncthreads();
    pg8::gemm_phase<EpiResid8, pg8::StaticOrder, true, true, false>((PG8_LAS unsigned char*)lds, g, S, epi);
    __syncthreads();
  } else if (sp == 4) {
    phase_ln(p, p.ln_attn_g + l * 1024, p.ln_attn_b + l * 1024, mod + 3 * 1024, mod + 4 * 1024, false, bid, nb);
  } else if (sp == 5) {
    const EpiUp8 epi{p.U, lds + EPI8_OFF};
    const pg8::Gemm g{p.H, p.wt_up + (size_t)l * 4096 * 1024, NTOK, 4096, 1024};
    pg8::StaticOrder S; S.init(NTOK, 4096, nb, bid);
    __syncthreads();
    pg8::gemm_phase<EpiUp8, pg8::StaticOrder, true, true, false>((PG8_LAS unsigned char*)lds, g, S, epi);
    __syncthreads();
  } else if (sp == 6) {
    const EpiResid8 epi{p.out, p.out, mod + 5 * 1024, p.lnstat, p.ln_attn_g + l * 1024, p.ln_attn_b + l * 1024, lds + EPI8_OFF};
    const pg8::Gemm g{p.U, p.wt_down + (size_t)l * 1024 * 4096, NTOK, 1024, 4096};
    pg8::StaticOrder S; S.init(NTOK, 1024, nb, bid);
    __syncthreads();
    pg8::gemm_phase<EpiResid8, pg8::StaticOrder, true, true, false>((PG8_LAS unsigned char*)lds, g, S, epi);
    __syncthreads();
  } else {
    const float* nmod = p.mod + (size_t)(l + 1) * 8 * 6144;
    if (bid == 0 && l == 0) for (int i = tidx(); i < 6144; i += 512) p.nmax[i] = 0u;
    phase_ln(p, p.ln_mlp_g + l * 1024, p.ln_mlp_b + l * 1024, l == 0 ? nmod : nullptr, l == 0 ? nmod + 1024 : nullptr, l == 1, bid, nb);
  }
}

#if MULTI_LAUNCH
template <int PH> __global__ void __launch_bounds__(512) k_ph(Params p) {
  __shared__ __attribute__((aligned(16))) char smem[LDS_BYTES];
  run_phase(p, PH, smem, blockIdx.x, gridDim.x);
}
#else
__global__ void __launch_bounds__(512) k_mega(Params p) {
  __shared__ __attribute__((aligned(16))) char smem[LDS_BYTES + 8 * EPI8_IMG + 64];
  cg::grid_group grid = cg::this_grid();
  volatile LAS unsigned* st = (volatile LAS unsigned*)(LAS char*)(smem + LDS_BYTES + 8 * EPI8_IMG);
  if (threadIdx.x < 2) st[threadIdx.x] = 0u;
  __syncthreads();
  const XcdBarrier xb = xcd_barrier_post(p.bar, st);
#define GSYNC_ xcd_barrier(xb)
#define PH_(n) run_phase(p, n, smem, blockIdx.x, gridDim.x)
  PH_(0); grid.sync(); PH_(1); GSYNC_;
  PH_(2); GSYNC_; PH_(3); GSYNC_; PH_(4); GSYNC_; PH_(5); GSYNC_; PH_(6); GSYNC_; PH_(7); GSYNC_; PH_(8); GSYNC_; PH_(9); GSYNC_;
  PH_(10); GSYNC_; PH_(11); GSYNC_; PH_(12); GSYNC_; PH_(13); GSYNC_; PH_(14); GSYNC_; PH_(15); GSYNC_; PH_(16); GSYNC_; PH_(17);
#if PROBE_DUP == 7
  for (int i_ = 0; i_ < 10; ++i_) GSYNC_;
#endif
#undef PH_
}
#endif

extern "C" void kernel_launch(void* const* d_in, const int* in_sizes, int n_in, void* d_out, int out_size, void* d_ws, size_t ws_size, hipStream_t stream) {
  Params p{};
  const float** f = (const float**)&p;
  for (int i = 0; i < 20; ++i) f[i] = (const float*)d_in[i];
  p.out = (float*)d_out;
  char* w = (char*)d_ws; size_t o = 0;
  auto take = [&](size_t bytes) { char* r = w + o; o += (bytes + 255) & ~(size_t)255; return r; };
  p.wt_in = (bf16_t*)take((size_t)2 * 2816 * 1024 * 2);
  p.wt_o = (bf16_t*)take((size_t)2 * 1024 * 1024 * 2);
  p.wt_up = (bf16_t*)take((size_t)2 * 4096 * 1024 * 2);
  p.wt_down = (bf16_t*)take((size_t)2 * 4096 * 1024 * 2);
  p.wt_uq = (bf16_t*)take((size_t)2 * 512 * 384 * 2);
  p.wt_ukv = (bf16_t*)take((size_t)2 * 512 * 256 * 2);
  p.modp = (float*)take((size_t)8 * 2 * 8 * 6144 * 4);
  p.mod = (float*)take((size_t)2 * 8 * 6144 * 4);
  p.rope = (float*)take((size_t)4096 * 16 * 2 * 4);
  p.ssq = (float*)take((size_t)NTOK * 16 * 4);
  p.dlse = (float*)take((size_t)3 * NTOK * 4 * 4);
  p.lnstat = (float*)take((size_t)NTOK * 2 * 4);
  p.bar = (unsigned*)take((size_t)XCD_BAR_WORDS * 4);
  p.nmax = (unsigned*)take((size_t)(6144 + 64) * 4);
  p.H = (bf16_t*)take((size_t)NTOK * 1024 * 2);
  p.dpart = p.H;
  char* R = w + o;
  p.proj = (bf16_t*)take((size_t)NTOK * LDP * 2);
  p.qb = (bf16_t*)take((size_t)NTOK * 384 * 2);
  p.knb = (bf16_t*)take((size_t)NTOK * 256 * 2);
  p.vta = (bf16_t*)take((size_t)8 * 4 * 64 * 4096 * 2);
  p.vtb = (bf16_t*)take((size_t)8 * 4 * 64 * 4096 * 2);
  p.vtc = (bf16_t*)take((size_t)8 * 2 * 64 * 4096 * 2);
  p.Y = (bf16_t*)take((size_t)NTOK * 1024 * 2);
  p.U = (bf16_t*)R;
  static int grid_blocks = 0;
#if MULTI_LAUNCH
  grid_blocks = 256;
#define L_(n) hipLaunchKernelGGL(k_ph<n>, dim3(grid_blocks), dim3(512), 0, stream, p)
  L_(0); L_(1); L_(2); L_(3); L_(4); L_(5); L_(6); L_(7); L_(8); L_(9); L_(10); L_(11); L_(12); L_(13); L_(14); L_(15); L_(16); L_(17);
#undef L_
#else
  if (!grid_blocks) { int dev = 0, cus = 0, per_cu = 0; hipGetDevice(&dev); hipDeviceGetAttribute(&cus, hipDeviceAttributeMultiprocessorCount, dev);
    hipOccupancyMaxActiveBlocksPerMultiprocessor(&per_cu, k_mega, 512, 0); if (per_cu < 1) per_cu = 1; grid_blocks = cus * per_cu; }
  hipMemsetAsync(p.bar, 0, (size_t)XCD_BAR_WORDS * 4, stream);
  void* args[] = {&p};
  hipError_t e = hipLaunchCooperativeKernel((void*)k_mega, dim3(grid_blocks), dim3(512), args, 0, stream);
  if (e != hipSuccess) fprintf(stderr, "cooperative launch failed: %s (grid %d)\n", hipGetErrorString(e), grid_blocks);
#endif
}
```

```cpp
#include <hip/hip_runtime.h>
#include <hip/hip_cooperative_groups.h>
#include <stdint.h>
#include <cstdio>
namespace cg = cooperative_groups;

#ifndef PROBE_DUP
#define PROBE_DUP 0
#endif
#ifndef MULTI_LAUNCH
#define MULTI_LAUNCH 0
#endif

typedef unsigned short bf16_t;
typedef short bf16x8 __attribute__((ext_vector_type(8)));
typedef short s16x4 __attribute__((ext_vector_type(4)));
typedef float f32x16 __attribute__((ext_vector_type(16)));
typedef float f32x4 __attribute__((ext_vector_type(4)));
typedef float f32x2 __attribute__((ext_vector_type(2)));
typedef unsigned u32x4 __attribute__((ext_vector_type(4)));
typedef unsigned u32x2 __attribute__((ext_vector_type(2)));
typedef __bf16 bf2_t __attribute__((ext_vector_type(2)));
#define DI __device__ __forceinline__

constexpr int NTOK = 32768, SEQ = 4096, DM = 1024, LDP = 2816;
constexpr int C_AQ = 0, C_AK = 256, C_BCQ = 768, C_BCKV = 1152, C_CQ = 1408, C_CK = 1664, C_DQ = 1920, C_DK = 2176, C_DV = 2432, C_BKR = 2688;
constexpr float LOG2E = 1.4426950408889634f;
constexpr float SC_A = 0.17677669529663687f * LOG2E;
constexpr float SC_B = 0.10206207261596575f * LOG2E;
constexpr float SC_C = 0.125f * LOG2E;
constexpr float ALPHA = 1.4142135623730951f;
constexpr int LDS_BYTES = 131072;

struct Params {
  const float *x, *c, *w_ada, *b_ada, *w_in, *w_o, *diff_lambda, *diff_subln_g, *mla_q_norm_g, *mla_w_uq, *mla_kv_norm_g, *mla_w_ukv,
      *gqa_q_norm_g, *gqa_k_norm_g, *ln_attn_g, *ln_attn_b, *w_up, *w_down, *ln_mlp_g, *ln_mlp_b;
  float* out;
  bf16_t *wt_in, *wt_o, *wt_up, *wt_down, *wt_uq, *wt_ukv;
  float *modp, *mod, *rope, *ssq, *dlse, *lnstat;
  unsigned* bar;
  unsigned* nmax;
  bf16_t *H, *proj, *qb, *knb, *vta, *vtb, *vtc, *Y, *U, *dpart;
};

DI int tidx() { int t = __builtin_amdgcn_workitem_id_x(); asm volatile("" : "+v"(t)); return t; }
DI unsigned pk2(float a, float b) { f32x2 v = {a, b}; bf2_t r = __builtin_convertvector(v, bf2_t); return __builtin_bit_cast(unsigned, r); }
DI void st4(bf16_t* p, float a, float b, float c, float d) { u32x2 w = {pk2(a, b), pk2(c, d)}; *(u32x2*)p = w; }
DI f32x16 mfma32(bf16x8 a, bf16x8 b, f32x16 c) { return __builtin_amdgcn_mfma_f32_32x32x16_bf16(a, b, c, 0, 0, 0); }
DI f32x16 zero16() { f32x16 z;
#pragma unroll
  for (int i = 0; i < 16; ++i) z[i] = 0.f; return z; }
DI float max3f(float a, float b, float c) { float d; asm("v_max3_f32 %0, %1, %2, %3" : "=v"(d) : "v"(a), "v"(b), "v"(c)); return d; }
DI float bflo(unsigned u) { return __uint_as_float(u << 16); }
DI float bfhi(unsigned u) { return __uint_as_float(u & 0xffff0000u); }

DI void rope32(f32x16& v, const float* __restrict__ rope, int pos, int lh) {
  const float* t = rope + (size_t)pos * 32 + 8 * lh;
#pragma unroll
  for (int g = 0; g < 2; ++g) {
    const f32x4 c0 = *(const f32x4*)(t + g * 16), c1 = *(const f32x4*)(t + g * 16 + 4);
    float x1, x2;
    x1 = v[4 * g + 0]; x2 = v[4 * g + 8];  v[4 * g + 0] = x1 * c0[0] - x2 * c0[1]; v[4 * g + 8]  = x2 * c0[0] + x1 * c0[1];
    x1 = v[4 * g + 1]; x2 = v[4 * g + 9];  v[4 * g + 1] = x1 * c0[2] - x2 * c0[3]; v[4 * g + 9]  = x2 * c0[2] + x1 * c0[3];
    x1 = v[4 * g + 2]; x2 = v[4 * g + 10]; v[4 * g + 2] = x1 * c1[0] - x2 * c1[1]; v[4 * g + 10] = x2 * c1[0] + x1 * c1[1];
    x1 = v[4 * g + 3]; x2 = v[4 * g + 11]; v[4 * g + 3] = x1 * c1[2] - x2 * c1[3]; v[4 * g + 11] = x2 * c1[2] + x1 * c1[3];
  }
}
DI float ssq16(const f32x16& v) { float s = 0.f;
#pragma unroll
  for (int i = 0; i < 16; ++i) s += v[i] * v[i]; return s; }
DI void store_tile(bf16_t* dst, const f32x16& v, int lh, float sc) {
#pragma unroll
  for (int g = 0; g < 4; ++g) st4(dst + 8 * g + 4 * lh, v[4 * g] * sc, v[4 * g + 1] * sc, v[4 * g + 2] * sc, v[4 * g + 3] * sc);
}

DI void store_rows64(char* ldsw, bf16_t* dst, size_t ld, const f32x16& v0, const f32x16& v1, int lane, float sc) {
  const int lr = lane & 31, lh = lane >> 5;
  char* wr = ldsw + lr * 144 + 8 * lh;
#pragma unroll
  for (int g = 0; g < 4; ++g) {
    u32x2 a = {pk2(v0[4 * g] * sc, v0[4 * g + 1] * sc), pk2(v0[4 * g + 2] * sc, v0[4 * g + 3] * sc)};
    u32x2 b = {pk2(v1[4 * g] * sc, v1[4 * g + 1] * sc), pk2(v1[4 * g + 2] * sc, v1[4 * g + 3] * sc)};
    *(u32x2*)(wr + 16 * g) = a; *(u32x2*)(wr + 64 + 16 * g) = b;
  }
  asm volatile("" ::: "memory");
  const int rr = lane >> 3, pc = lane & 7;
#pragma unroll
  for (int it = 0; it < 4; ++it) {
    const u32x4 d = *(const u32x4*)(ldsw + (it * 8 + rr) * 144 + pc * 16);
    *(u32x4*)(dst + (size_t)(it * 8 + rr) * ld + pc * 8) = d;
  }
  asm volatile("" ::: "memory");
}

#define LAS __attribute__((address_space(3)))
constexpr int G_STAGE = 65536, G_BOFF = 32768;
template <bool VM>
DI void g_compute(f32x16 (&acc)[4][2], const LAS char* buf, int aofs, int bofs, int o0) {
#pragma unroll
  for (int ks = 0; ks < 4; ++ks) {
    const int oo = o0 ^ (ks << 5);
    bf16x8 a[4], b[2];
#pragma unroll
    for (int i = 0; i < 4; ++i) a[i] = *(const LAS bf16x8*)(buf + aofs + i * 4096 + oo);
#pragma unroll
    for (int j = 0; j < 2; ++j) b[j] = *(const LAS bf16x8*)(buf + bofs + j * 4096 + oo);
#pragma unroll
    for (int i = 0; i < 4; ++i)
#pragma unroll
      for (int j = 0; j < 2; ++j) acc[i][j] = VM ? mfma32(a[i], b[j], acc[i][j]) : mfma32(b[j], a[i], acc[i][j]);
  }
}
constexpr int EPI_LDS = G_STAGE;
template <bool VM, class Epi>
DI void gemm_loop(char* lds_g, const bf16_t* __restrict__ A, int lda, const bf16_t* __restrict__ Bt, int ldb, int K, int first, int stride, int total, int npn, int pn0, const Epi& epi) {
  if (first >= total) return;
  LAS char* lds = (LAS char*)lds_g;
  const int tid = tidx(), lane = tid & 63, wid = __builtin_amdgcn_readfirstlane(tid >> 6), wm = wid >> 2, wn = wid & 3, lr = lane & 31, lh = lane >> 5;
  const int grow = lane >> 3, gc = ((lane & 7) ^ ((wid & 1) * 4 + (lane >> 4))) * 8;
  const size_t a64 = (size_t)64 * lda, b64 = (size_t)64 * ldb;
  const bf16_t* gA; const bf16_t* gB;
  auto issue = [&](int kt, int stage) __attribute__((always_inline)) {
    LAS char* sb = lds + stage * G_STAGE + wid * 1024;
#pragma unroll
    for (int e = 0; e < 4; ++e) __builtin_amdgcn_global_load_lds((const unsigned*)(gA + e * a64 + kt * 64), (LAS unsigned*)(sb + e * 8192), 16, 0, 0);
#pragma unroll
    for (int e = 0; e < 4; ++e) __builtin_amdgcn_global_load_lds((const unsigned*)(gB + e * b64 + kt * 64), (LAS unsigned*)(sb + G_BOFF + e * 8192), 16, 0, 0);
  };
  int nk = K >> 6;
  asm volatile("" : "+s"(nk));
  const int swz = (lr >> 1) & 7, o0 = (lh ^ swz) * 16;
  const int aofs = (wm * 128 + lr) * 128, bofs = G_BOFF + (wn * 64 + lr) * 128;
  const bool xmap = (stride == 256) && (npn >= 2) && (total == 128 * npn);
  const int sn = npn < 8 ? npn : 8, sm = 32 / sn, xn = npn / sn, Rm = sm * (8 / xn), xx = first & 7, kk = first >> 3;
  auto tile_of = [&](int it, int& pm_, int& pn_) __attribute__((always_inline)) -> bool {
    if (xmap) { pm_ = it * Rm + (xx / xn) * sm + kk / sn; pn_ = pn0 + (xx % xn) * sn + kk % sn; return pm_ < 128; }
    const int t_ = first + it * stride; pm_ = t_ / npn; pn_ = pn0 + t_ % npn; return t_ < total;
  };
  int it = 0, pm, pn;
  tile_of(0, pm, pn);
  gA = A + (size_t)(pm * 256 + wid * 8 + grow) * lda + gc; gB = Bt + (size_t)(pn * 256 + wid * 8 + grow) * ldb + gc;
  __syncthreads();
  issue(0, 0);
  for (;;) {
    f32x16 acc[4][2];
#pragma unroll
    for (int i = 0; i < 4; ++i)
#pragma unroll
      for (int j = 0; j < 2; ++j) acc[i][j] = zero16();
    asm volatile("s_waitcnt vmcnt(0)" ::: "memory"); __builtin_amdgcn_s_barrier(); asm volatile("" ::: "memory");
    for (int kt = 0; kt < nk; ++kt) {
      if (kt + 1 < nk) issue(kt + 1, (kt + 1) & 1);
      g_compute<VM>(acc, lds + (kt & 1) * G_STAGE, aofs, bofs, o0);
      asm volatile("s_waitcnt vmcnt(0)" ::: "memory");
      __builtin_amdgcn_s_barrier(); asm volatile("" ::: "memory");
    }
    int pm2 = pm, pn2 = pn; const bool has_next = tile_of(it + 1, pm2, pn2);
    if (has_next) { gA = A + (size_t)(pm2 * 256 + wid * 8 + grow) * lda + gc; gB = Bt + (size_t)(pn2 * 256 + wid * 8 + grow) * ldb + gc; issue(0, 0); }
    epi.template run<VM>(acc, pm, pn, wm, wn, lr, lh, lds_g);
    if (!has_next) break;
    ++it; pm = pm2; pn = pn2;
  }
  __syncthreads();
}

struct EpiInProj {
  const Params& p; int layer;
  template <bool VM> DI void run(f32x16 (&acc)[4][2], int pm, int pn, int wm, int wn, int lr, int lh, char* lds) const {
    const int hu = pn * 4 + wn, tok0 = pm * 256 + wm * 128;
    if constexpr (VM) {
      bf16_t* vt = p.vta; const int head = hu - 8, nh = 4;
      const int b = tok0 >> 12, s0 = tok0 & 4095;
#pragma unroll
      for (int i = 0; i < 4; ++i)
#pragma unroll
        for (int j = 0; j < 2; ++j) {
          bf16_t* dst = vt + ((size_t)((b * nh + head) * 64 + j * 32 + lr)) * 4096 + s0 + i * 32 + 4 * lh;
#pragma unroll
          for (int g = 0; g < 4; ++g) st4(dst + 8 * g, acc[i][j][4 * g], acc[i][j][4 * g + 1], acc[i][j][4 * g + 2], acc[i][j][4 * g + 3]);
        }
    } else {
      if (hu == 43) return;
      if (hu == 28 || hu == 29) {
        const int b = tok0 >> 12, s0 = tok0 & 4095;
#pragma unroll
        for (int i = 0; i < 4; ++i)
#pragma unroll
          for (int j = 0; j < 2; ++j)
#pragma unroll
            for (int r = 0; r < 16; ++r) { const int d = j * 32 + (r & 3) + 8 * (r >> 2) + 4 * lh;
              p.vtc[((size_t)((b * 2 + hu - 28) * 64 + d)) * 4096 + s0 + i * 32 + lr] = (bf16_t)(pk2(acc[i][j][r], 0.f) & 0xffffu); }
        return;
      }
#pragma unroll
      for (int i = 0; i < 4; ++i) {
        const int token = tok0 + i * 32 + lr, s = token & 4095;
        f32x16 v0 = acc[i][0], v1 = acc[i][1];
        float sc = 1.f;
        if (hu < 4) sc = SC_A;
        if (hu < 8) {
          float n0 = ssq16(v0), n1 = ssq16(v1);
          n0 += __shfl_xor(n0, 32); n1 += __shfl_xor(n1, 32);
#pragma unroll
          for (int o = 16; o > 0; o >>= 1) { n0 = fmaxf(n0, __shfl_xor(n0, o)); n1 = fmaxf(n1, __shfl_xor(n1, o)); }
          if (lr == 0 && lh == 0) {
            const int bb = token >> 12;
            if (hu < 4) { const int idx = 4096 + ((bb * 4 + hu) * 2) * 32 + (s >> 7);
              atomicMax(p.nmax + idx, __float_as_uint(n0 * SC_A * SC_A)); atomicMax(p.nmax + idx + 32, __float_as_uint(n1 * SC_A * SC_A)); }
            else { const int idx = ((bb * 4 + hu - 4) * 2) * 64 + (s >> 6);
              atomicMax(p.nmax + idx, __float_as_uint(n0)); atomicMax(p.nmax + idx + 64, __float_as_uint(n1)); }
          }
        }
        else if (hu >= 12 && hu < 22) {
          float q = ssq16(v0) + ssq16(v1); q += __shfl_xor(q, 32);
          if (lh == 0) p.ssq[(size_t)token * 16 + (hu - 12)] = q;
        } else if (hu >= 22 && hu < 28) {
          float q = ssq16(v0) + ssq16(v1); q += __shfl_xor(q, 32);
          const float rinv = rsqrtf(q * (1.f / 64.f) + 1e-6f);
          const float* g = (hu < 26 ? p.gqa_q_norm_g : p.gqa_k_norm_g) + layer * 64 + 4 * lh;
#pragma unroll
          for (int gg = 0; gg < 4; ++gg) { const f32x4 g0 = *(const f32x4*)(g + 8 * gg), g1 = *(const f32x4*)(g + 32 + 8 * gg);
#pragma unroll
            for (int e = 0; e < 4; ++e) { v0[4 * gg + e] *= rinv * g0[e]; v1[4 * gg + e] *= rinv * g1[e]; } }
          rope32(v0, p.rope, s >> 6, lh); rope32(v1, p.rope, s & 63, lh);
          if (hu < 26) sc = SC_C;
        } else if (hu >= 30 && hu < 34) sc = SC_C;
        else if (hu == 42) rope32(v0, p.rope, s, lh);
        store_rows64(lds + EPI_LDS + (wm * 4 + wn) * 4608, p.proj + (size_t)(tok0 + i * 32) * LDP + hu * 64, LDP, v0, v1, lh * 32 + lr, sc);
      }
    }
  }
};

template <int KIND> struct EpiMla {
  const Params& p;
  DI bool vm(int hu) const { return KIND == 1 && hu >= 4; }
  template <bool VM> DI void run(f32x16 (&acc)[4][2], int pm, int pn, int wm, int wn, int lr, int lh, char* lds) const {
    float* sR = (float*)(lds + EPI_LDS + 8 * 4608);
    const int tid = tidx();
    if (tid < 256) { const float* q = p.ssq + (size_t)(pm * 256 + tid) * 16; float s;
      if (KIND == 0) { s = ((q[0] + q[1]) + (q[2] + q[3])) + (q[4] + q[5]); s = rsqrtf(s * (1.f / 384.f) + 1e-6f); }
      else { s = (q[6] + q[7]) + (q[8] + q[9]); s = rsqrtf(s * (1.f / 256.f) + 1e-6f); }
      sR[tid] = s; }
    __syncthreads();
    const int hu = pn * 4 + wn, tok0 = pm * 256 + wm * 128;
    if constexpr (VM) {
      const int b = tok0 >> 12, s0 = tok0 & 4095, head = hu - 4;
#pragma unroll
      for (int i = 0; i < 4; ++i)
#pragma unroll
        for (int j = 0; j < 2; ++j) {
          bf16_t* dst = p.vtb + ((size_t)((b * 4 + head) * 64 + j * 32 + lr)) * 4096 + s0 + i * 32 + 4 * lh;
#pragma unroll
          for (int g = 0; g < 4; ++g) { const f32x4 r = *(const f32x4*)(sR + wm * 128 + i * 32 + 8 * g + 4 * lh);
            st4(dst + 8 * g, acc[i][j][4 * g] * r[0], acc[i][j][4 * g + 1] * r[1], acc[i][j][4 * g + 2] * r[2], acc[i][j][4 * g + 3] * r[3]); }
        }
    } else {
#pragma unroll
      for (int i = 0; i < 4; ++i) {
        const int token = tok0 + i * 32 + lr, s = token & 4095;
        const float rinv = sR[wm * 128 + i * 32 + lr];
        f32x16 v0 = acc[i][0] * rinv, v1 = acc[i][1] * rinv;
        if (KIND == 0) {
          if (hu >= 6) continue;
          if (hu >= 4) { rope32(v0, p.rope, s, lh); rope32(v1, p.rope, s, lh); }
          store_rows64(lds + EPI_LDS + (wm * 4 + wn) * 4608, p.qb + (size_t)(tok0 + i * 32) * 384 + hu * 64, 384, v0, v1, lh * 32 + lr, SC_B);
        } else {
          store_rows64(lds + EPI_LDS + (wm * 4 + wn) * 4608, p.knb + (size_t)(tok0 + i * 32) * 256 + hu * 64, 256, v0, v1, lh * 32 + lr, 1.f);
        }
      }
    }
    __syncthreads();
  }
};

struct EpiResid {
  const float* xsrc; float* out; const float* gate;
  const float* stat; const float* lng; const float* lnb;
  template <bool VM> DI void run(f32x16 (&acc)[4][2], int pm, int pn, int wm, int wn, int lr, int lh, char* lds) const {
    const int tok0 = pm * 256 + wm * 128, b = tok0 >> 12, lane = lh * 32 + lr, rr = lane >> 3, pc = lane & 7;
    char* img = lds + EPI_LDS + (wm * 4 + wn) * 4608;
#pragma unroll
    for (int j = 0; j < 2; ++j) {
      const int col = pn * 256 + wn * 64 + j * 32 + pc * 4;
      const f32x4 gt = *(const f32x4*)(gate + b * 6144 + col);
      f32x4 lg = {1.f, 1.f, 1.f, 1.f}, lb = {0.f, 0.f, 0.f, 0.f};
      if (stat) { lg = *(const f32x4*)(lng + col); lb = *(const f32x4*)(lnb + col); }
#pragma unroll
      for (int i = 0; i < 4; ++i) {
#pragma unroll
        for (int g = 0; g < 4; ++g) { const f32x4 v = {acc[i][j][4 * g], acc[i][j][4 * g + 1], acc[i][j][4 * g + 2], acc[i][j][4 * g + 3]}; *(f32x4*)(img + lr * 144 + (8 * g + 4 * lh) * 4) = v; }
        asm volatile("" ::: "memory");
#pragma unroll
        for (int it = 0; it < 4; ++it) {
          const f32x4 a = *(const f32x4*)(img + (it * 8 + rr) * 144 + pc * 16);
          const size_t off = (size_t)(tok0 + i * 32 + it * 8 + rr) * DM + col;
          f32x4 xi = *(const f32x4*)(xsrc + off);
          if (stat) { const f32x2 ms = *(const f32x2*)(stat + (size_t)(tok0 + i * 32 + it * 8 + rr) * 2); xi = (xi - ms[0]) * ms[1] * lg + lb; }
          *(f32x4*)(out + off) = ALPHA * xi + gt * a;
        }
        asm volatile("" ::: "memory");
      }
    }
  }
};
struct EpiUp {
  bf16_t* U;
  template <bool VM> DI void run(f32x16 (&acc)[4][2], int pm, int pn, int wm, int wn, int lr, int lh, char* lds) const {
    const int tok0 = pm * 256 + wm * 128;
#pragma unroll
    for (int i = 0; i < 4; ++i) {
      f32x16 v0, v1;
#pragma unroll
      for (int r = 0; r < 16; ++r) { const float a = fmaxf(acc[i][0][r], 0.f), b = fmaxf(acc[i][1][r], 0.f); v0[r] = a * a; v1[r] = b * b; }
      store_rows64(lds + EPI_LDS + (wm * 4 + wn) * 4608, U + (size_t)(tok0 + i * 32) * 4096 + pn * 256 + wn * 64, 4096, v0, v1, lh * 32 + lr, 1.f);
    }
  }
};

template <int MODE>
DI void attn_unit(char* lds, const Params& p, int layer, int u) {
  constexpr int NKS = MODE == 0 ? 2 : (MODE == 1 ? 6 : 4);
  constexpr int KST = MODE == 1 ? 208 : 144;
  constexpr int VOFF = 64 * KST, VST = 144, BUFSZ = VOFF + 64 * VST;
  const int tid = tidx(), lane = tid & 63, wid = tid >> 6, lr = lane & 31, lh = lane >> 5;
  int b, h, q0, dl = 1, rho = 0, br = 0, L = SEQ, comp = 0;
  if (MODE == 0) { h = u >> 8; b = (u >> 5) & 7; q0 = (u & 31) * 128; comp = wid >> 2; }
  else if (MODE == 1 || MODE == 2) { h = (u >> 4) & 3; b = u >> 6; q0 = (u & 15) * 256; }
  else { br = u >> 9; const int r = u & 511; b = r >> 6; h = (r >> 4) & 3; const int xx = r & 15; dl = 1 << (2 * br); rho = xx & (dl - 1); q0 = (xx >> (2 * br)) * 256; L = SEQ >> (2 * br); }
  const int qrow = (MODE == 0) ? q0 + (wid & 3) * 32 + lr : q0 + wid * 32 + lr;
  const int token = (MODE == 3) ? b * SEQ + rho + dl * qrow : b * SEQ + qrow;
  int NT = (MODE == 3) ? 6 : 64, tlo = 0;
  if (MODE == 0) {
    const float sl2 = exp2f(-(float)(2 * h + 1)) * LOG2E;
    const unsigned* km = p.nmax + ((b * 4 + h) * 2) * 64; const unsigned* qm = p.nmax + 4096 + ((b * 4 + h) * 2) * 32 + (q0 >> 7);
    const float q0n = 1.02f * sqrtf(__uint_as_float(qm[0])), q1n = 1.02f * sqrtf(__uint_as_float(qm[32]));
    const int td = q0 >> 6;
    const float kd0 = sqrtf(fmaxf(__uint_as_float(km[td]), __uint_as_float(km[td + 1]))), kd1 = sqrtf(fmaxf(__uint_as_float(km[64 + td]), __uint_as_float(km[64 + td + 1])));
    const float thr0 = -q0n * kd0 - 40.f, thr1 = -q1n * kd1 - 40.f;
    int lo = td, hi = td + 1;
    for (int T = 0; T < 64; ++T) {
      const int dmin = (T < td) ? (q0 - (64 * T + 63)) : ((T > td + 1) ? (64 * T - (q0 + 127)) : 0);
      const float pen = sl2 * (float)dmin;
      const bool need = (q0n * sqrtf(__uint_as_float(km[T])) - pen >= thr0) || (q1n * sqrtf(__uint_as_float(km[64 + T])) - pen >= thr1);
      if (need) { lo = T < lo ? T : lo; hi = T > hi ? T : hi; }
    }
    tlo = __builtin_amdgcn_readfirstlane(lo); NT = __builtin_amdgcn_readfirstlane(hi - lo + 1);
  }
  bf16x8 qf[NKS];
  if constexpr (MODE == 0) { const bf16_t* q = p.proj + (size_t)token * LDP + C_AQ + h * 64 + comp * 32 + lh * 8;
#pragma unroll
    for (int ks = 0; ks < NKS; ++ks) qf[ks] = *(const bf16x8*)(q + ks * 16); }
  else if constexpr (MODE == 1) { const bf16_t* q = p.qb + (size_t)token * 384 + lh * 8;
#pragma unroll
    for (int ks = 0; ks < 4; ++ks) qf[ks] = *(const bf16x8*)(q + h * 64 + ks * 16);
#pragma unroll
    for (int ks = 4; ks < 6; ++ks) qf[ks] = *(const bf16x8*)(q + 256 + h * 32 + (ks - 4) * 16); }
  else { const bf16_t* q = p.proj + (size_t)token * LDP + (MODE == 2 ? C_CQ : C_DQ) + h * 64 + lh * 8;
#pragma unroll
    for (int ks = 0; ks < NKS; ++ks) qf[ks] = *(const bf16x8*)(q + ks * 16); }
  const bf16_t* vtbase = (MODE == 0) ? p.vta + (size_t)((b * 4 + h) * 64) * 4096 : (MODE == 1) ? p.vtb + (size_t)((b * 4 + h) * 64) * 4096 : p.vtc + (size_t)((b * 2 + (h >> 1)) * 64) * 4096;
  float slope2 = 0.f;
  if (MODE == 0) slope2 = exp2f(-(float)(2 * h + 1)) * LOG2E;
  if (MODE == 3) slope2 = exp2f(-(float)(2 * h + 2)) * LOG2E * (float)dl;
  const int srow = tid >> 3, sc = tid & 7;
  u32x4 kr0, kr2, vr0;
  kr2 = (u32x4){0u, 0u, 0u, 0u};
  auto prefetch = [&](int t) __attribute__((always_inline)) {
    const int key0 = (MODE == 3) ? q0 - 64 + 64 * t : 64 * (tlo + t);
    if (MODE != 3) {
      const size_t tokk = (size_t)(b * SEQ + key0 + srow);
      const bf16_t* kp = (MODE == 0) ? p.proj + tokk * LDP + C_AK + h * 64 : (MODE == 1) ? p.knb + tokk * 256 + h * 64 : p.proj + tokk * LDP + C_CK + (h >> 1) * 64;
      kr0 = *(const u32x4*)(kp + sc * 8);
      if (MODE == 1) kr2 = *(const u32x4*)(p.proj + tokk * LDP + C_BKR + (sc & 3) * 8);
      vr0 = *(const u32x4*)(vtbase + (size_t)srow * 4096 + key0 + sc * 8);
    } else {
      int v = key0 + srow; v = v < 0 ? 0 : (v >= L ? L - 1 : v);
      const bf16_t* kp = p.proj + (size_t)(b * SEQ + rho + dl * v) * LDP + h * 64;
      kr0 = *(const u32x4*)(kp + C_DK + sc * 8);
      vr0 = *(const u32x4*)(kp + C_DV + sc * 8);
    }
  };
  auto stage = [&](char* buf) __attribute__((always_inline)) {
    char* kd = buf + srow * KST + sc * 16;
    *(u32x4*)kd = kr0;
    if (MODE == 1) { if (sc < 4) *(u32x4*)(buf + srow * KST + 128 + sc * 16) = kr2; }
    if (MODE != 3) { *(u32x4*)(buf + VOFF + srow * VST + sc * 16) = vr0; }
    else {
      bf16_t* vd = (bf16_t*)(buf + VOFF) + srow;
#pragma unroll
      for (int e = 0; e < 4; ++e) { vd[(sc * 8 + 2 * e) * 72] = (bf16_t)(vr0[e] & 0xffffu); vd[(sc * 8 + 2 * e + 1) * 72] = (bf16_t)(vr0[e] >> 16); }
    }
  };
  f32x16 O0 = zero16(), O1 = zero16();
  float m = -1e30f, l = 0.f;
  f32x16 T0 = zero16(), T1 = zero16();
  if (MODE == 0) {
#pragma unroll
    for (int r = 0; r < 16; ++r) { const float cc = (float)((r & 3) + 8 * (r >> 2)); T0[r] = slope2 * cc; T1[r] = slope2 * (cc + 32.f); }
  }
  const int qlo = q0 + (wid & 3) * 32;
  prefetch(0);
  __syncthreads();
  stage(lds);
  prefetch(1);
  __syncthreads();
  for (int t = 0; t < NT; ++t) {
    char* cur = lds + (t & 1) * BUFSZ;
    if (t + 1 < NT) { stage(lds + ((t + 1) & 1) * BUFSZ); if (t + 2 < NT) prefetch(t + 2); }
    const int key0 = (MODE == 3) ? q0 - 64 + 64 * t : 64 * (tlo + t);
    const bool act = (MODE != 3) || (t >= (wid >> 1) && t <= (wid >> 1) + 2);
    if (act) {
      f32x16 S0 = zero16(), S1 = zero16();
      const char* kb = cur + lr * KST + (MODE == 0 ? comp * 64 : 0) + lh * 16;
#pragma unroll
      for (int ks = 0; ks < NKS; ++ks) {
        const bf16x8 k0 = *(const bf16x8*)(kb + ks * 32), k1 = *(const bf16x8*)(kb + 32 * KST + ks * 32);
        S0 = mfma32(k0, qf[ks], S0); S1 = mfma32(k1, qf[ks], S1);
      }
      float aoff = 0.f;
      if (MODE == 0) {
        const float dbase = (float)(key0 + 4 * lh - qrow);
        if (key0 > qlo + 31) { S0 = S0 - T0; S1 = S1 - T1; aoff = -slope2 * dbase; }
        else if (key0 + 63 < qlo) { S0 = S0 + T0; S1 = S1 + T1; aoff = slope2 * dbase; }
        else {
#pragma unroll
          for (int r = 0; r < 16; ++r) { const float cc = (float)((r & 3) + 8 * (r >> 2));
            S0[r] = fmaf(-slope2, fabsf(dbase + cc), S0[r]); S1[r] = fmaf(-slope2, fabsf(dbase + cc + 32.f), S1[r]); }
        }
      }
      if (MODE == 3) {
        const int rel0 = key0 + 4 * lh - qrow;
#pragma unroll
        for (int r = 0; r < 16; ++r) { const int cc = (r & 3) + 8 * (r >> 2);
          { const int rel = rel0 + cc, v = qrow + rel; const bool ok = (rel >= -64) && (rel <= 64) && (v >= 0) && (v < L); S0[r] = ok ? fmaf(-slope2, fabsf((float)rel), S0[r]) : -1e30f; }
          { const int rel = rel0 + cc + 32, v = qrow + rel; const bool ok = (rel >= -64) && (rel <= 64) && (v >= 0) && (v < L); S1[r] = ok ? fmaf(-slope2, fabsf((float)rel), S1[r]) : -1e30f; } }
      }
      float mx = fmaxf(S0[0], S1[0]);
#pragma unroll
      for (int r = 1; r < 16; ++r) mx = max3f(mx, S0[r], S1[r]);
      mx += aoff;
      if (__any(mx > m + 8.f)) {
        mx = fmaxf(mx, __shfl_xor(mx, 32));
        const float mnew = fmaxf(m, mx);
        const float al = __builtin_amdgcn_exp2f(m - mnew); l *= al; O0 *= al; O1 *= al;
        m = mnew;
      }
      { const f32x2 nm = {aoff - m, aoff - m};
#pragma unroll
        for (int r = 0; r < 8; ++r) {
          f32x2 a = {S0[2 * r], S0[2 * r + 1]}, b = {S1[2 * r], S1[2 * r + 1]};
          asm("v_pk_add_f32 %0, %1, %2" : "=v"(a) : "v"(a), "v"(nm));
          asm("v_pk_add_f32 %0, %1, %2" : "=v"(b) : "v"(b), "v"(nm));
          S0[2 * r] = a[0]; S0[2 * r + 1] = a[1]; S1[2 * r] = b[0]; S1[2 * r + 1] = b[1];
        } }
#pragma unroll
      for (int r = 0; r < 16; ++r) { S0[r] = __builtin_amdgcn_exp2f(S0[r]); S1[r] = __builtin_amdgcn_exp2f(S1[r]); }
      const f32x16 SS = S0 + S1;
      float ps = 0.f;
#pragma unroll
      for (int r = 0; r < 16; ++r) ps += SS[r];
      l += ps;
      bf16x8 pf[4];
#pragma unroll
      for (int s = 0; s < 4; ++s) {
        u32x4 w;
        if (s < 2) { w[0] = pk2(S0[8 * s], S0[8 * s + 1]); w[1] = pk2(S0[8 * s + 2], S0[8 * s + 3]); w[2] = pk2(S0[8 * s + 4], S0[8 * s + 5]); w[3] = pk2(S0[8 * s + 6], S0[8 * s + 7]); }
        else { const int s2 = s - 2; w[0] = pk2(S1[8 * s2], S1[8 * s2 + 1]); w[1] = pk2(S1[8 * s2 + 2], S1[8 * s2 + 3]); w[2] = pk2(S1[8 * s2 + 4], S1[8 * s2 + 5]); w[3] = pk2(S1[8 * s2 + 6], S1[8 * s2 + 7]); }
        pf[s] = __builtin_bit_cast(bf16x8, w);
      }
      const char* vb = cur + VOFF + lr * VST + lh * 8;
#pragma unroll
      for (int s = 0; s < 4; ++s) {
        { const s16x4 lo = *(const s16x4*)(vb + s * 32), hi = *(const s16x4*)(vb + s * 32 + 16);
          O0 = mfma32(__builtin_shufflevector(lo, hi, 0, 1, 2, 3, 4, 5, 6, 7), pf[s], O0); }
        { const s16x4 lo = *(const s16x4*)(vb + 32 * VST + s * 32), hi = *(const s16x4*)(vb + 32 * VST + s * 32 + 16);
          O1 = mfma32(__builtin_shufflevector(lo, hi, 0, 1, 2, 3, 4, 5, 6, 7), pf[s], O1); }
      }
    }
    __syncthreads();
  }
  l += __shfl_xor(l, 32);
  const float inv = 1.f / l;
  O0 *= inv; O1 *= inv;
  if (MODE == 1 || MODE == 2) {
    bf16_t* dst = p.Y + (size_t)token * DM + (MODE == 1 ? 256 : 512) + h * 64;
    store_tile(dst, O0, lh, 1.f); store_tile(dst + 32, O1, lh, 1.f);
  } else if (MODE == 3) {
    bf16_t* dst = p.dpart + ((size_t)br * NTOK + token) * 256 + h * 64;
    store_tile(dst, O0, lh, 1.f); store_tile(dst + 32, O1, lh, 1.f);
    if (lh == 0) p.dlse[((size_t)br * NTOK + token) * 4 + h] = m + log2f(l);
  } else {
    float* xb = (float*)lds + (wid & 3) * 2048 + lane;
    if (comp == 1) {
#pragma unroll
      for (int r = 0; r < 16; ++r) { xb[r * 64] = O0[r]; xb[(16 + r) * 64] = O1[r]; }
    }
    __syncthreads();
    if (comp == 0) {
      const float* dlm = p.diff_lambda + layer * 128;
      float s1 = 0.f, s2 = 0.f;
      for (int i = 0; i < 32; ++i) { s1 += dlm[i] * dlm[32 + i]; s2 += dlm[64 + i] * dlm[96 + i]; }
      const float lambda_init = 0.8f - 0.6f * expf(-0.3f * (float)layer);
      const float lam = expf(s1) - expf(s2) + lambda_init;
      float q = 0.f;
#pragma unroll
      for (int r = 0; r < 16; ++r) { O0[r] -= lam * xb[r * 64]; O1[r] -= lam * xb[(16 + r) * 64]; q += O0[r] * O0[r] + O1[r] * O1[r]; }
      q += __shfl_xor(q, 32);
      const float rinv = rsqrtf(q * (1.f / 64.f) + 1e-6f) * (1.f - lambda_init);
      const float* g = p.diff_subln_g + layer * 64 + 4 * lh;
#pragma unroll
      for (int gg = 0; gg < 4; ++gg) { const f32x4 g0 = *(const f32x4*)(g + 8 * gg), g1 = *(const f32x4*)(g + 32 + 8 * gg);
#pragma unroll
        for (int e = 0; e < 4; ++e) { O0[4 * gg + e] *= rinv * g0[e]; O1[4 * gg + e] *= rinv * g1[e]; } }
      bf16_t* dst = p.Y + (size_t)token * DM + h * 64;
      store_tile(dst, O0, lh, 1.f); store_tile(dst + 32, O1, lh, 1.f);
    }
  }
}

DI void attn_d6_unit(char* lds, const Params& p, int layer, int u) {
  constexpr int KST = 144, VOFF = 384 * KST;
  const int tid = tidx(), lane = tid & 63, wid = tid >> 6, lr = lane & 31, lh = lane >> 5;
  const int br = u >> 9, r = u & 511, b = r >> 6, h = (r >> 4) & 3, xx = r & 15, dl = 1 << (2 * br), rho = xx & (dl - 1), q0 = (xx >> (2 * br)) * 256, L = SEQ >> (2 * br);
  const int qrow = q0 + wid * 32 + lr, token = b * SEQ + rho + dl * qrow;
  bf16x8 qf[4];
  { const bf16_t* q = p.proj + (size_t)token * LDP + C_DQ + h * 64 + lh * 8;
#pragma unroll
    for (int ks = 0; ks < 4; ++ks) qf[ks] = *(const bf16x8*)(q + ks * 16); }
  const float slope2 = exp2f(-(float)(2 * h + 2)) * LOG2E * (float)dl;
  const int srow = tid >> 3, sc = tid & 7;
  u32x4 kr[6], vr[6];
#pragma unroll
  for (int c = 0; c < 6; ++c) {
    int v = q0 - 64 + 64 * c + srow; v = v < 0 ? 0 : (v >= L ? L - 1 : v);
    const bf16_t* kp = p.proj + (size_t)(b * SEQ + rho + dl * v) * LDP + h * 64 + sc * 8;
    kr[c] = *(const u32x4*)(kp + C_DK); vr[c] = *(const u32x4*)(kp + C_DV);
  }
  __syncthreads();
#pragma unroll
  for (int c = 0; c < 6; ++c) {
    *(u32x4*)(lds + (64 * c + srow) * KST + sc * 16) = kr[c];
    *(u32x4*)(lds + VOFF + (64 * c + srow) * KST + sc * 16) = vr[c];
  }
  __syncthreads();
  f32x16 O0 = zero16(), O1 = zero16();
  float m = -1e30f, l = 0.f;
#pragma unroll 1
  for (int c = wid >> 1; c <= (wid >> 1) + 2; ++c) {
#pragma unroll
    for (int hf = 0; hf < 2; ++hf) {
      const bool skip = (hf == 0) ? ((wid & 1) && c == (wid >> 1)) : (!(wid & 1) && c == (wid >> 1) + 2);
      if (skip) continue;
      const int key0 = q0 - 64 + 64 * c + 32 * hf;
      f32x16 S = zero16();
      const char* kb = lds + (64 * c + 32 * hf + lr) * KST + lh * 16;
#pragma unroll
      for (int ks = 0; ks < 4; ++ks) S = mfma32(*(const bf16x8*)(kb + ks * 32), qf[ks], S);
      const int rel0 = key0 + 4 * lh - qrow;
#pragma unroll
      for (int r2 = 0; r2 < 16; ++r2) { const int rel = rel0 + (r2 & 3) + 8 * (r2 >> 2), v = qrow + rel;
        const bool ok = (rel >= -64) && (rel <= 64) && (v >= 0) && (v < L); S[r2] = ok ? fmaf(-slope2, fabsf((float)rel), S[r2]) : -1e30f; }
      float mx = S[0];
#pragma unroll
      for (int r2 = 1; r2 < 15; r2 += 2) mx = max3f(mx, S[r2], S[r2 + 1]);
      mx = fmaxf(mx, S[15]);
      if (__any(mx > m + 8.f)) {
        mx = fmaxf(mx, __shfl_xor(mx, 32));
        const float mnew = fmaxf(m, mx);
        const float al = __builtin_amdgcn_exp2f(m - mnew); l *= al; O0 *= al; O1 *= al;
        m = mnew;
      }
      float ps = 0.f;
#pragma unroll
      for (int r2 = 0; r2 < 16; ++r2) { S[r2] = __builtin_amdgcn_exp2f(S[r2] - m); ps += S[r2]; }
      l += ps;
      bf16x8 pf[2];
#pragma unroll
      for (int s2 = 0; s2 < 2; ++s2) { u32x4 w; w[0] = pk2(S[8 * s2], S[8 * s2 + 1]); w[1] = pk2(S[8 * s2 + 2], S[8 * s2 + 3]); w[2] = pk2(S[8 * s2 + 4], S[8 * s2 + 5]); w[3] = pk2(S[8 * s2 + 6], S[8 * s2 + 7]);
        pf[s2] = __builtin_bit_cast(bf16x8, w); }
      { const int g = lane >> 4, i16 = lane & 15;
        const unsigned vbase = (unsigned)(size_t)(lds + VOFF) + (unsigned)((64 * c + 32 * hf + 4 * (g >> 1) + (i16 >> 2)) * KST + ((g & 1) * 16 + 4 * (i16 & 3)) * 2);
#pragma unroll
        for (int s2 = 0; s2 < 2; ++s2) {
          s16x4 l0, h0, l1, h1;
          const unsigned a0 = vbase + (unsigned)(16 * s2 * KST), a1 = a0 + 8u * KST, a2 = a0 + 64u, a3 = a1 + 64u;
          asm volatile("ds_read_b64_tr_b16 %0, %4\n\tds_read_b64_tr_b16 %1, %5\n\tds_read_b64_tr_b16 %2, %6\n\tds_read_b64_tr_b16 %3, %7\n\ts_waitcnt lgkmcnt(0)"
                       : "=&v"(l0), "=&v"(h0), "=&v"(l1), "=&v"(h1) : "v"(a0), "v"(a1), "v"(a2), "v"(a3) : "memory");
          O0 = mfma32(__builtin_shufflevector(l0, h0, 0, 1, 2, 3, 4, 5, 6, 7), pf[s2], O0);
          O1 = mfma32(__builtin_shufflevector(l1, h1, 0, 1, 2, 3, 4, 5, 6, 7), pf[s2], O1);
        } }
    }
  }
  l += __shfl_xor(l, 32);
  const float inv = 1.f / l;
  O0 *= inv; O1 *= inv;
  bf16_t* dst = p.dpart + ((size_t)br * NTOK + token) * 256 + h * 64;
  store_tile(dst, O0, lh, 1.f); store_tile(dst + 32, O1, lh, 1.f);
  if (lh == 0) p.dlse[((size_t)br * NTOK + token) * 4 + h] = m + log2f(l);
}

DI void dcombine_unit(const Params& p, int u) {
#pragma unroll
  for (int e = 0; e < 2; ++e) {
    const int idx = u * 1024 + e * 512 + tidx(), token = idx >> 5, rem = idx & 31, h = rem >> 3, dc = rem & 7;
    float ls[3], mx = -1e30f;
#pragma unroll
    for (int n = 0; n < 3; ++n) { ls[n] = p.dlse[((size_t)n * NTOK + token) * 4 + h]; mx = fmaxf(mx, ls[n]); }
    float w[3], ws = 0.f;
#pragma unroll
    for (int n = 0; n < 3; ++n) { w[n] = exp2f(ls[n] - mx); ws += w[n]; }
    const float inv = 1.f / ws;
    float o[8];
#pragma unroll
    for (int i = 0; i < 8; ++i) o[i] = 0.f;
#pragma unroll
    for (int n = 0; n < 3; ++n) { const u32x4 d = *(const u32x4*)(p.dpart + ((size_t)n * NTOK + token) * 256 + h * 64 + dc * 8); const float wn = w[n] * inv;
#pragma unroll
      for (int i = 0; i < 4; ++i) { o[2 * i] += wn * bflo(d[i]); o[2 * i + 1] += wn * bfhi(d[i]); } }
    u32x4 r = {pk2(o[0], o[1]), pk2(o[2], o[3]), pk2(o[4], o[5]), pk2(o[6], o[7])};
    *(u32x4*)(p.Y + (size_t)token * DM + 768 + h * 64 + dc * 8) = r;
  }
}


namespace pg8 {
#define PG8_LAS __attribute__((address_space(3)))
typedef unsigned short bf16_t;
typedef short bf16x8 __attribute__((ext_vector_type(8)));
typedef float f32x4 __attribute__((ext_vector_type(4)));
typedef unsigned u32x4 __attribute__((ext_vector_type(4)));
constexpr int BM = 256, BK = 64, HALF = 128, HTB = HALF * BK * 2  , STAGE_BYTES = 8 * HTB, NXCD = 8, WGM = 8;

__host__ __device__ __forceinline__ int lds_byte(int r, int c) { const int st = (r >> 4) * 2 + (c >> 5), rr = r & 15, cc = c & 31, ob = rr * 64 + cc * 2; return st * 1024 + (ob ^ (((ob >> 9) & 1) << 5)); }
__host__ __device__ __forceinline__ void stage_rc(int b, int& R, int& C) { const int st = b / 1024, sb = b % 1024, swz = sb ^ (((sb >> 9) & 1) << 5); R = (st >> 1) * 16 + swz / 64; C = (st & 1) * 32 + (swz % 64) / 2; }
__host__ __device__ __forceinline__ int perm32(int rho) { const int n = rho >> 4, i = rho & 15; return 8 * (i >> 2) + 4 * n + (i & 3); }

struct Unit { int pm, pn; };
struct Gemm { const bf16_t* A; const bf16_t* Bt; int M, N, K; };

struct StaticOrder {
    int nM, nN, nwg, G, c;
    __host__ __device__ void init(int M, int N, int G_, int c_) { nM = M / BM; nN = N / BM; nwg = nM * nN; G = G_; c = c_; }
    __host__ __device__ bool next(int i, Unit& u) const {
        const long L = (long)i * G + c; if (L >= nwg) return false;
        int wgid = (int)L; { const int q = nwg / NXCD, r = nwg % NXCD, xcd = wgid % NXCD, off = wgid / NXCD; wgid = (xcd < r ? xcd * (q + 1) : r * (q + 1) + (xcd - r) * q) + off; }
        const int nig = WGM * nN, gid = wgid / nig, fm = gid * WGM, gsz = (nM - fm) < WGM ? (nM - fm) : WGM;
        u.pm = fm + ((wgid % nig) % gsz); u.pn = (wgid % nig) / gsz; return true;
    }
    __device__ __forceinline__ void a_ready(const Unit&) const {}
    __device__ __forceinline__ void done(const Unit&) const {}
};

typedef float f32x2 __attribute__((ext_vector_type(2)));
template <class Epi, class Sched, bool ALIGN_EPI = false, bool SP2 = false, bool VM = false>
__device__ __forceinline__ void gemm_phase(PG8_LAS unsigned char* lds, const Gemm g, const Sched& S, const Epi& E) {
    const int tid = tidx(), wid = __builtin_amdgcn_readfirstlane(tid >> 6), lane = tid & 63, wr = wid >> 2, wc = wid & 3, fr = lane & 15, fq = lane >> 4;
    const int K = g.K, nt = K / BK;
    unsigned voffA[2], voffB[2];
#pragma unroll
    for (int i = 0; i < 2; ++i) { int R, C; stage_rc(tid * 16 + i * 8192, R, C); const int Rb = Epi::PERM ? ((R & ~31) + perm32(R & 31)) : R;
        voffA[i] = (unsigned)(R * K + C) * 2u; voffB[i] = (unsigned)(Rb * K + C) * 2u; }
    const size_t kstep = (size_t)(BK * 2);
    const size_t hstep = (size_t)HALF * K * 2;
    const size_t tstep = 2 * hstep;
    const unsigned ldsw = (unsigned)wid * 1024u;
    const int aoff = lds_byte(wr * 64 + fr, fq * 8), boff = lds_byte(wc * 32 + fr, fq * 8);
#define PG8_SA(b, h) (((b) * 2 + (h)) * HTB)
#define PG8_SB(b, h) ((4 + (b) * 2 + (h)) * HTB)
#define PG8_STAGE(bufoff, gbase, voff) do { _Pragma("unroll") for (int _i = 0; _i < 2; ++_i) \
        __builtin_amdgcn_global_load_lds((const unsigned*)((const char*)(gbase) + (voff)[_i]), (PG8_LAS unsigned*)(lds + (bufoff) + ldsw + _i * 8192), 16, 0, 0); } while (0)
#define PG8_LDA(dst, b, h) do { _Pragma("unroll") for (int m = 0; m < 4; ++m) _Pragma("unroll") for (int k = 0; k < 2; ++k) dst[m][k] = *(const PG8_LAS bf16x8*)(lds + PG8_SA(b, h) + aoff + m * 2048 + k * 1024); } while (0)
#define PG8_LDB(dst, b, h) do { _Pragma("unroll") for (int n = 0; n < 2; ++n) _Pragma("unroll") for (int k = 0; k < 2; ++k) dst[n][k] = *(const PG8_LAS bf16x8*)(lds + PG8_SB(b, h) + boff + n * 2048 + k * 1024); } while (0)
#define PG8_MMA(ai, bj, At, Bt) do { __builtin_amdgcn_s_setprio(1); _Pragma("unroll") for (int m = 0; m < 4; ++m) _Pragma("unroll") for (int n = 0; n < 2; ++n) _Pragma("unroll") for (int k = 0; k < 2; ++k) \
        acc[ai][bj][m][n] = VM ? __builtin_amdgcn_mfma_f32_16x16x32_bf16(At[m][k], Bt[n][k], acc[ai][bj][m][n], 0, 0, 0) : __builtin_amdgcn_mfma_f32_16x16x32_bf16(Bt[n][k], At[m][k], acc[ai][bj][m][n], 0, 0, 0); __builtin_amdgcn_s_setprio(0); } while (0)
#define PG8_WAIT_V(n) asm volatile("s_waitcnt vmcnt(" #n ")" ::: "memory")
#define PG8_WAIT_L(n) asm volatile("s_waitcnt lgkmcnt(" #n ")" ::: "memory")
#define PG8_BAR __builtin_amdgcn_s_barrier()
#define PG8_SCHED __builtin_amdgcn_sched_barrier(0)
    Unit cur, nxt; int ui = 0;
    if (!S.next(0, cur)) return;
    f32x4 acc[2][2][4][2];
#pragma unroll
    for (int a = 0; a < 2; ++a)
#pragma unroll
        for (int b = 0; b < 2; ++b)
#pragma unroll
            for (int m = 0; m < 4; ++m)
#pragma unroll
                for (int n = 0; n < 2; ++n) acc[a][b][m][n] = (f32x4){0.f, 0.f, 0.f, 0.f};
    bf16x8 At[4][2], B0[2][2], B1[2][2];
    const char* cA = (const char*)g.A + (size_t)cur.pm * tstep; const char* cB = (const char*)g.Bt + (size_t)cur.pn * tstep;
    S.a_ready(cur);
    if constexpr (SP2) {
        PG8_STAGE(PG8_SB(0, 0), cB, voffB); PG8_STAGE(PG8_SB(0, 1), cB + hstep, voffB); PG8_STAGE(PG8_SA(0, 0), cA, voffA); PG8_STAGE(PG8_SA(0, 1), cA + hstep, voffA);
        if (wr == 1) PG8_BAR;
        PG8_WAIT_V(2); PG8_BAR;
        PG8_STAGE(PG8_SB(1, 0), cB + kstep, voffB); PG8_STAGE(PG8_SA(1, 0), cA + kstep, voffA); PG8_STAGE(PG8_SB(1, 1), cB + hstep + kstep, voffB);
        PG8_WAIT_V(6); PG8_BAR;
    } else {
        PG8_STAGE(PG8_SB(0, 0), cB, voffB); PG8_STAGE(PG8_SA(0, 0), cA, voffA); PG8_STAGE(PG8_SB(0, 1), cB + hstep, voffB); PG8_STAGE(PG8_SA(0, 1), cA + hstep, voffA);
        if (wr == 1) PG8_BAR;
        PG8_WAIT_V(4); PG8_BAR;
        PG8_STAGE(PG8_SB(1, 0), cB + kstep, voffB); PG8_STAGE(PG8_SA(1, 0), cA + kstep, voffA); PG8_STAGE(PG8_SB(1, 1), cB + hstep + kstep, voffB);
        PG8_WAIT_V(6); PG8_BAR;
    }
    for (;;) {
        const bool has_next = S.next(ui + 1, nxt);
        const char* nA = has_next ? (const char*)g.A + (size_t)nxt.pm * tstep : cA; const char* nB = has_next ? (const char*)g.Bt + (size_t)nxt.pn * tstep : cB;
        for (int t = 0; t < nt; t += 2) {
            const bool last = (t == nt - 2);
            const char* a1 = cA + (size_t)(t + 1) * kstep;
            const char* a2 = last ? nA : cA + (size_t)(t + 2) * kstep; const char* b2 = last ? nB : cB + (size_t)(t + 2) * kstep;
            const char* a3 = a2 + kstep; const char* b3 = b2 + kstep;
            if (last && has_next) S.a_ready(nxt);
            if constexpr (SP2) {
            PG8_LDB(B0, 0, 0); PG8_LDB(B1, 0, 1); PG8_SCHED; PG8_LDA(At, 0, 0); PG8_STAGE(PG8_SA(1, 1), a1 + hstep, voffA);
            PG8_WAIT_V(8); PG8_WAIT_L(0); PG8_BAR; PG8_MMA(0, 0, At, B0); PG8_MMA(0, 1, At, B1); PG8_BAR; PG8_SCHED;
            PG8_LDA(At, 0, 1); PG8_STAGE(PG8_SB(0, 0), b2, voffB); PG8_STAGE(PG8_SB(0, 1), b2 + hstep, voffB); PG8_STAGE(PG8_SA(0, 0), a2, voffA);
            PG8_WAIT_V(8); PG8_WAIT_L(0); PG8_BAR; PG8_MMA(1, 0, At, B0); PG8_MMA(1, 1, At, B1); PG8_BAR; PG8_SCHED;
            PG8_LDB(B0, 1, 0); PG8_LDB(B1, 1, 1); PG8_SCHED; PG8_LDA(At, 1, 0); PG8_STAGE(PG8_SA(0, 1), a2 + hstep, voffA);
            PG8_WAIT_V(8); PG8_WAIT_L(0); PG8_BAR; PG8_MMA(0, 0, At, B0); PG8_MMA(0, 1, At, B1); PG8_BAR; PG8_SCHED;
            PG8_LDA(At, 1, 1); PG8_STAGE(PG8_SB(1, 0), b3, voffB); PG8_STAGE(PG8_SB(1, 1), b3 + hstep, voffB); PG8_STAGE(PG8_SA(1, 0), a3, voffA);
            PG8_WAIT_V(8); PG8_WAIT_L(0); PG8_BAR; PG8_MMA(1, 0, At, B0); PG8_MMA(1, 1, At, B1); PG8_BAR; PG8_SCHED;
            } else {
            PG8_LDB(B0, 0, 0); PG8_SCHED; PG8_LDA(At, 0, 0); PG8_STAGE(PG8_SA(1, 1), a1 + hstep, voffA);
            PG8_WAIT_L(8); PG8_BAR; PG8_WAIT_L(0); PG8_MMA(0, 0, At, B0); PG8_BAR; PG8_SCHED;
            PG8_LDB(B1, 0, 1); PG8_STAGE(PG8_SB(0, 0), b2, voffB);
            PG8_BAR; PG8_WAIT_L(0); PG8_MMA(0, 1, At, B1); PG8_BAR;
            PG8_LDA(At, 0, 1); PG8_STAGE(PG8_SA(0, 0), a2, voffA);
            PG8_BAR; PG8_WAIT_L(0); PG8_MMA(1, 0, At, B0); PG8_BAR; PG8_SCHED;
            PG8_STAGE(PG8_SB(0, 1), b2 + hstep, voffB);
            PG8_WAIT_V(6); PG8_BAR; PG8_MMA(1, 1, At, B1); PG8_BAR;
            PG8_LDB(B0, 1, 0); PG8_SCHED; PG8_LDA(At, 1, 0); PG8_STAGE(PG8_SA(0, 1), a2 + hstep, voffA);
            PG8_WAIT_L(8); PG8_BAR; PG8_WAIT_L(0); PG8_MMA(0, 0, At, B0); PG8_BAR; PG8_SCHED;
            PG8_LDB(B1, 1, 1); PG8_STAGE(PG8_SB(1, 0), b3, voffB);
            PG8_BAR; PG8_WAIT_L(0); PG8_MMA(0, 1, At, B1); PG8_BAR;
            PG8_LDA(At, 1, 1); PG8_STAGE(PG8_SA(1, 0), a3, voffA);
            PG8_BAR; PG8_WAIT_L(0); PG8_MMA(1, 0, At, B0); PG8_BAR; PG8_SCHED;
            PG8_STAGE(PG8_SB(1, 1), b3 + hstep, voffB);
            PG8_WAIT_V(6); PG8_BAR; PG8_MMA(1, 1, At, B1); PG8_BAR;
            }
        }
        if constexpr (ALIGN_EPI) { if (wr == 0) PG8_BAR; }
        if constexpr (!Epi::AFTER_DRAIN) { E(acc, cur, wr, wc, fr, fq); S.done(cur); }
        if (!has_next) break;
#pragma unroll
        for (int a = 0; a < 2; ++a)
#pragma unroll
            for (int b = 0; b < 2; ++b)
#pragma unroll
                for (int m = 0; m < 4; ++m)
#pragma unroll
                    for (int n = 0; n < 2; ++n) acc[a][b][m][n] = (f32x4){0.f, 0.f, 0.f, 0.f};
        cur = nxt; cA = nA; cB = nB; ++ui;
        if constexpr (ALIGN_EPI) { if (wr == 1) PG8_BAR; }
    }
    PG8_WAIT_V(0);
    if constexpr (!ALIGN_EPI) { if (wr == 0) PG8_BAR; }
    PG8_BAR;
    if constexpr (Epi::AFTER_DRAIN) { E.fused(acc, cur, wr, wc, fr, fq, lds, wid, lane); S.done(cur); }
#undef PG8_SA
#undef PG8_SB
#undef PG8_STAGE
#undef PG8_LDA
#undef PG8_LDB
#undef PG8_MMA
#undef PG8_WAIT_V
#undef PG8_WAIT_L
#undef PG8_BAR
#undef PG8_SCHED
}
}

constexpr int EPI8_OFF = 131072, EPI8_IMG = 2304;
DI int logical_col(int n) { return (n & ~255) | (((n >> 5) & 3) << 6) | (((n >> 7) & 1) << 5) | (n & 31); }
DI void store16x64_bf16(char* img, bf16_t* dst, size_t ld, const f32x4 (&v)[2][2], int fr, int fq, float sc) {
  char* wp = img + fr * 144 + fq * 8;
#pragma unroll
  for (int bj = 0; bj < 2; ++bj)
#pragma unroll
    for (int n = 0; n < 2; ++n) { u32x2 w = {pk2(v[bj][n][0] * sc, v[bj][n][1] * sc), pk2(v[bj][n][2] * sc, v[bj][n][3] * sc)}; *(u32x2*)(wp + bj * 64 + n * 32) = w; }
  asm volatile("" ::: "memory");
  const int lane = fq * 16 + fr, rr = lane >> 2, pc = (lane & 3) * 2;
#pragma unroll
  for (int k = 0; k < 2; ++k) { const u32x4 d = *(const u32x4*)(img + rr * 144 + (pc + k) * 16); *(u32x4*)(dst + (size_t)rr * ld + (pc + k) * 8) = d; }
  asm volatile("" ::: "memory");
}
DI void rope_grp(f32x4& lo, f32x4& hi, const float* __restrict__ rope, int pos, int fq) {
  const float* t = rope + (size_t)pos * 32 + 8 * fq;
  const f32x4 c0 = *(const f32x4*)t, c1 = *(const f32x4*)(t + 4);
  float x1, x2;
  x1 = lo[0]; x2 = hi[0]; lo[0] = x1 * c0[0] - x2 * c0[1]; hi[0] = x2 * c0[0] + x1 * c0[1];
  x1 = lo[1]; x2 = hi[1]; lo[1] = x1 * c0[2] - x2 * c0[3]; hi[1] = x2 * c0[2] + x1 * c0[3];
  x1 = lo[2]; x2 = hi[2]; lo[2] = x1 * c1[0] - x2 * c1[1]; hi[2] = x2 * c1[0] + x1 * c1[1];
  x1 = lo[3]; x2 = hi[3]; lo[3] = x1 * c1[2] - x2 * c1[3]; hi[3] = x2 * c1[2] + x1 * c1[3];
}
DI float ssq4(const f32x4& a) { return (a[0] * a[0] + a[1] * a[1]) + (a[2] * a[2] + a[3] * a[3]); }

struct EpiInProj8 {
  static constexpr bool PERM = false, AFTER_DRAIN = false;
  const Params* pp; int layer; char* img0;
  DI void operator()(const pg8::f32x4 (&acc)[2][2][4][2], const pg8::Unit& u, int wr, int wc, int fr, int fq) const {
    asm volatile("" : "+v"(fr), "+v"(fq));
    const Params& p = *pp;
    const int hu = u.pn * 4 + wc;
    if (hu == 43) return;
    char* img = img0 + (wr * 4 + wc) * EPI8_IMG;
    const int bb = (u.pm * 256) >> 12;
#pragma unroll
    for (int ai = 0; ai < 2; ++ai) {
      float nm0 = 0.f, nm1 = 0.f;
#pragma unroll
      for (int m = 0; m < 4; ++m) {
        __builtin_amdgcn_sched_barrier(0);
        const int token = u.pm * 256 + 128 * ai + 64 * wr + 16 * m + fr, s = token & 4095;
        f32x4 v[2][2];
#pragma unroll
        for (int bj = 0; bj < 2; ++bj)
#pragma unroll
          for (int n = 0; n < 2; ++n) v[bj][n] = acc[ai][bj][m][n];
        if (hu == 28 || hu == 29) {
#pragma unroll
          for (int bj = 0; bj < 2; ++bj)
#pragma unroll
            for (int n = 0; n < 2; ++n)
#pragma unroll
              for (int e = 0; e < 4; ++e) { const int d = 32 * bj + 16 * n + 4 * fq + e;
                p.vtc[((size_t)((bb * 2 + hu - 28) * 64 + d)) * 4096 + s] = (bf16_t)(pk2(v[bj][n][e], 0.f) & 0xffffu); }
          continue;
        }
        float sc = 1.f;
        if (hu < 4) sc = SC_A;
        if (hu < 8) {
          float n0 = ssq4(v[0][0]) + ssq4(v[0][1]), n1 = ssq4(v[1][0]) + ssq4(v[1][1]);
          n0 += __shfl_xor(n0, 16); n0 += __shfl_xor(n0, 32); n1 += __shfl_xor(n1, 16); n1 += __shfl_xor(n1, 32);
          nm0 = fmaxf(nm0, n0); nm1 = fmaxf(nm1, n1);
        } else if (hu >= 12 && hu < 22) {
          float q = (ssq4(v[0][0]) + ssq4(v[0][1])) + (ssq4(v[1][0]) + ssq4(v[1][1]));
          q += __shfl_xor(q, 16); q += __shfl_xor(q, 32);
          if (fq == 0) p.ssq[(size_t)token * 16 + (hu - 12)] = q;
        } else if (hu >= 22 && hu < 28) {
          float q = (ssq4(v[0][0]) + ssq4(v[0][1])) + (ssq4(v[1][0]) + ssq4(v[1][1]));
          q += __shfl_xor(q, 16); q += __shfl_xor(q, 32);
          const float rinv = rsqrtf(q * (1.f / 64.f) + 1e-6f);
          const float* g = (hu < 26 ? p.gqa_q_norm_g : p.gqa_k_norm_g) + layer * 64 + 4 * fq;
#pragma unroll
          for (int bj = 0; bj < 2; ++bj)
#pragma unroll
            for (int n = 0; n < 2; ++n) v[bj][n] = v[bj][n] * rinv * *(const f32x4*)(g + 32 * bj + 16 * n);
          rope_grp(v[0][0], v[0][1], p.rope, s >> 6, fq); rope_grp(v[1][0], v[1][1], p.rope, s & 63, fq);
          if (hu < 26) sc = SC_C;
        } else if (hu >= 30 && hu < 34) sc = SC_C;
        else if (hu == 42) rope_grp(v[0][0], v[0][1], p.rope, s, fq);
        store16x64_bf16(img, p.proj + (size_t)(token - fr) * LDP + hu * 64, LDP, v, fr, fq, sc);
      }
      if (hu < 8) {
#pragma unroll
        for (int o = 8; o > 0; o >>= 1) { nm0 = fmaxf(nm0, __shfl_xor(nm0, o)); nm1 = fmaxf(nm1, __shfl_xor(nm1, o)); }
        if (fr == 0 && fq == 0) {
          const int s0 = (u.pm * 256 + 128 * ai + 64 * wr) & 4095;
          if (hu < 4) { const int idx = 4096 + ((bb * 4 + hu) * 2) * 32 + (s0 >> 7);
            atomicMax(p.nmax + idx, __float_as_uint(nm0 * SC_A * SC_A)); atomicMax(p.nmax + idx + 32, __float_as_uint(nm1 * SC_A * SC_A)); }
          else { const int idx = ((bb * 4 + hu - 4) * 2) * 64 + (s0 >> 6);
            atomicMax(p.nmax + idx, __float_as_uint(nm0)); atomicMax(p.nmax + idx + 64, __float_as_uint(nm1)); }
        }
      }
    }
  }
};
struct EpiVt8 {
  static constexpr bool PERM = false, AFTER_DRAIN = false;
  bf16_t* vt;
  DI void operator()(const pg8::f32x4 (&acc)[2][2][4][2], const pg8::Unit& u, int wr, int wc, int fr, int fq) const {
    const int bb = (u.pm * 256) >> 12;
#pragma unroll
    for (int ai = 0; ai < 2; ++ai)
#pragma unroll
      for (int m = 0; m < 4; ++m) { const int s = (u.pm * 256 + 128 * ai + 64 * wr + 16 * m + 4 * fq) & 4095;
#pragma unroll
        for (int bj = 0; bj < 2; ++bj)
#pragma unroll
          for (int n = 0; n < 2; ++n) { const int d = 32 * bj + 16 * n + fr; const pg8::f32x4 a = acc[ai][bj][m][n];
            st4(vt + ((size_t)((bb * 4 + wc) * 64 + d)) * 4096 + s, a[0], a[1], a[2], a[3]); } }
  }
};
struct EpiUp8 {
  static constexpr bool PERM = false, AFTER_DRAIN = false;
  bf16_t* U; char* img0;
  DI void operator()(const pg8::f32x4 (&acc)[2][2][4][2], const pg8::Unit& u, int wr, int wc, int fr, int fq) const {
    char* img = img0 + (wr * 4 + wc) * EPI8_IMG;
#pragma unroll
    for (int ai = 0; ai < 2; ++ai)
#pragma unroll
      for (int m = 0; m < 4; ++m) {
        f32x4 v[2][2];
#pragma unroll
        for (int bj = 0; bj < 2; ++bj)
#pragma unroll
          for (int n = 0; n < 2; ++n) { const pg8::f32x4 a = acc[ai][bj][m][n];
#pragma unroll
            for (int e = 0; e < 4; ++e) { const float t = fmaxf(a[e], 0.f); v[bj][n][e] = t * t; } }
        store16x64_bf16(img, U + (size_t)(u.pm * 256 + 128 * ai + 64 * wr + 16 * m) * 4096 + u.pn * 256 + wc * 64, 4096, v, fr, fq, 1.f);
      }
  }
};
struct EpiResid8 {
  static constexpr bool PERM = false, AFTER_DRAIN = false;
  const float* xsrc; float* out; const float* gate; const float* stat; const float* lng; const float* lnb; char* img0;
  DI void operator()(const pg8::f32x4 (&acc)[2][2][4][2], const pg8::Unit& u, int wr, int wc, int fr, int fq) const {
    char* img = img0 + (wr * 4 + wc) * EPI8_IMG;
    const int lane = fq * 16 + fr, rr = lane >> 2, pc = (lane & 3) * 2, bb = (u.pm * 256) >> 12;
#pragma unroll
    for (int bj = 0; bj < 2; ++bj) {
      const int col = u.pn * 256 + wc * 64 + 32 * bj + pc * 4;
      const f32x4 gt0 = *(const f32x4*)(gate + bb * 6144 + col), gt1 = *(const f32x4*)(gate + bb * 6144 + col + 4);
      f32x4 lg0 = {1.f, 1.f, 1.f, 1.f}, lg1 = lg0, lb0 = {0.f, 0.f, 0.f, 0.f}, lb1 = lb0;
      if (stat) { lg0 = *(const f32x4*)(lng + col); lg1 = *(const f32x4*)(lng + col + 4); lb0 = *(const f32x4*)(lnb + col); lb1 = *(const f32x4*)(lnb + col + 4); }
#pragma unroll
      for (int ai = 0; ai < 2; ++ai)
#pragma unroll
      for (int mh = 0; mh < 2; ++mh) {
        f32x4 xa[2][2]; f32x2 ms[2];
#pragma unroll
        for (int k = 0; k < 2; ++k) {
          const int row = u.pm * 256 + 128 * ai + 64 * wr + 16 * (2 * mh + k) + rr;
          const size_t off = (size_t)row * DM + col;
          xa[k][0] = *(const f32x4*)(xsrc + off); xa[k][1] = *(const f32x4*)(xsrc + off + 4);
          ms[k] = stat ? *(const f32x2*)(stat + (size_t)row * 2) : (f32x2){0.f, 1.f};
        }
#pragma unroll
        for (int k = 0; k < 2; ++k) {
          const int m = 2 * mh + k;
          *(f32x4*)(img + fr * 144 + fq * 16) = acc[ai][bj][m][0]; *(f32x4*)(img + fr * 144 + 64 + fq * 16) = acc[ai][bj][m][1];
          asm volatile("" ::: "memory");
          const f32x4 a0 = *(const f32x4*)(img + rr * 144 + pc * 16), a1 = *(const f32x4*)(img + rr * 144 + pc * 16 + 16);
          const int row = u.pm * 256 + 128 * ai + 64 * wr + 16 * m + rr;
          const size_t off = (size_t)row * DM + col;
          f32x4 x0 = xa[k][0], x1 = xa[k][1];
          if (stat) { x0 = (x0 - ms[k][0]) * ms[k][1] * lg0 + lb0; x1 = (x1 - ms[k][0]) * ms[k][1] * lg1 + lb1; }
          *(f32x4*)(out + off) = ALPHA * x0 + gt0 * a0; *(f32x4*)(out + off + 4) = ALPHA * x1 + gt1 * a1;
          asm volatile("" ::: "memory");
        }
      }
    }
  }
};
struct SkipOrder { pg8::StaticOrder S;
  __device__ bool next(int i, pg8::Unit& u) const { if (!S.next(i, u)) return false; if (u.pn >= 2) u.pn += 1; return true; }
  __device__ __forceinline__ void a_ready(const pg8::Unit&) const {} __device__ __forceinline__ void done(const pg8::Unit&) const {} };
struct ColOrder { int pn, first, G;
  __device__ bool next(int i, pg8::Unit& u) const { const int t = first + i * G; if (t >= 128) return false; u.pm = t; u.pn = pn; return true; }
  __device__ __forceinline__ void a_ready(const pg8::Unit&) const {} __device__ __forceinline__ void done(const pg8::Unit&) const {} };

DI int colmap(int kind, int n) {
  if (kind == 0 || kind == 3) n = logical_col(n);
  if (kind == 0) { if (n < 1408) return n; if (n < 2688) return n + 32; if (n < 2720) return n - 2688 + 1408; return -1; }
  if (kind == 1) { if (n >= 384) return -1; if (n < 256) return (n >> 6) * 96 + (n & 63); const int mm = n - 256; return (mm >> 5) * 96 + 64 + (mm & 31); }
  if (kind == 2) { if (n < 256) return (n >> 6) * 128 + (n & 63); const int mm = n - 256; return (mm >> 6) * 128 + 64 + (mm & 63); }
  return n;
}
DI void transpose_tile(char* lds, const float* __restrict__ in, int ldin, const float* __restrict__ scale, bf16_t* __restrict__ out, int Kdim, int kind, int nt, int kt) {
  float* tile = (float*)lds;
  const int tid = tidx(), n0 = nt * 64, k0 = kt * 64;
  {
    const int nl = (tid & 15) * 4, col = colmap(kind, n0 + nl);
#pragma unroll
    for (int rr = 0; rr < 2; ++rr) { const int kl = rr * 32 + (tid >> 4);
      f32x4 v = {0.f, 0.f, 0.f, 0.f}; if (col >= 0) { v = *(const f32x4*)(in + (size_t)(k0 + kl) * ldin + col); if (scale) v *= scale[k0 + kl]; }
      float* t = tile + kl * 65 + nl; t[0] = v[0]; t[1] = v[1]; t[2] = v[2]; t[3] = v[3]; }
  }
  __syncthreads();
  {
    const int nl = tid >> 3, kc = (tid & 7) * 8;
    float v[8];
#pragma unroll
    for (int e = 0; e < 8; ++e) v[e] = tile[(kc + e) * 65 + nl];
    bf16_t* dst = out + (size_t)(n0 + nl) * Kdim + k0 + kc;
    u32x4 w0 = {pk2(v[0], v[1]), pk2(v[2], v[3]), pk2(v[4], v[5]), pk2(v[6], v[7])};
    *(u32x4*)dst = w0;
  }
  __syncthreads();
}

constexpr int TR_PER_LAYER = 704 + 256 + 1024 + 1024 + 48 + 32;
DI void phase_prologue_a(char* lds, const Params& p, int bid, int nb) {
  const int total = 2 * TR_PER_LAYER + 192 + 128;
  for (int u = bid; u < total; u += nb) {
    if (u < 2 * TR_PER_LAYER) {
      const int l = u / TR_PER_LAYER; int r = u % TR_PER_LAYER;
      if (r < 704) { transpose_tile(lds, p.w_in + (size_t)l * 1024 * 2720, 2720, nullptr, p.wt_in + (size_t)l * 2816 * 1024, 1024, 0, r >> 4, r & 15); continue; } r -= 704;
      if (r < 256) { transpose_tile(lds, p.w_o + (size_t)l * 1024 * 1024, 1024, nullptr, p.wt_o + (size_t)l * 1024 * 1024, 1024, 3, r >> 4, r & 15); continue; } r -= 256;
      if (r < 1024) { transpose_tile(lds, p.w_up + (size_t)l * 1024 * 4096, 4096, nullptr, p.wt_up + (size_t)l * 4096 * 1024, 1024, 3, r >> 4, r & 15); continue; } r -= 1024;
      if (r < 1024) { transpose_tile(lds, p.w_down + (size_t)l * 4096 * 1024, 1024, nullptr, p.wt_down + (size_t)l * 1024 * 4096, 4096, 3, r >> 6, r & 63); continue; } r -= 1024;
      if (r < 48) { transpose_tile(lds, p.mla_w_uq + (size_t)l * 384 * 384, 384, p.mla_q_norm_g + l * 384, p.wt_uq + (size_t)l * 512 * 384, 384, 1, r / 6, r % 6); continue; } r -= 48;
      transpose_tile(lds, p.mla_w_ukv + (size_t)l * 256 * 512, 512, p.mla_kv_norm_g + l * 256, p.wt_ukv + (size_t)l * 512 * 256, 256, 2, r >> 2, r & 3);
    } else if (u < 2 * TR_PER_LAYER + 192) {
      const int r = u - 2 * TR_PER_LAYER, kc = r & 7, jb = (r >> 3) % 12, l = r / 96;
      float* sl = (float*)lds;
#pragma unroll
      for (int e = 0; e < 2; ++e) { const int i = tidx() + 512 * e, bb = i >> 7, k = i & 127; const float cv = p.c[bb * 1024 + kc * 128 + k]; sl[i] = cv / (1.f + expf(-cv)); }
      __syncthreads();
      const int j = jb * 512 + tidx();
      float a0 = 0.f, a1 = 0.f, a2 = 0.f, a3 = 0.f, a4 = 0.f, a5 = 0.f, a6 = 0.f, a7 = 0.f;
      const float* w = p.w_ada + ((size_t)l * 1024 + kc * 128) * 6144 + j;
#pragma unroll 4
      for (int k = 0; k < 128; ++k) { const float wv = w[(size_t)k * 6144];
        a0 += sl[k] * wv; a1 += sl[128 + k] * wv; a2 += sl[256 + k] * wv; a3 += sl[384 + k] * wv; a4 += sl[512 + k] * wv; a5 += sl[640 + k] * wv; a6 += sl[768 + k] * wv; a7 += sl[896 + k] * wv; }
      float* d = p.modp + ((size_t)(kc * 2 + l) * 8) * 6144 + j;
      d[0] = a0; d[6144] = a1; d[2 * 6144] = a2; d[3 * 6144] = a3; d[4 * 6144] = a4; d[5 * 6144] = a5; d[6 * 6144] = a6; d[7 * 6144] = a7;
      __syncthreads();
    } else {
      const int idx = (u - 2 * TR_PER_LAYER - 192) * 512 + tidx(), pos = idx >> 4, i = idx & 15;
      double fr = 1.0; for (int k = 0; k < i; ++k) fr *= 0.56234132519034908;
      const float ang = (float)pos * (float)fr;
      double a = (double)ang; a -= 6.283185307179586476925 * __builtin_rint(a * 0.15915494309189533577);
      const double tq = a * 0.125, t2 = tq * tq;
      double sn = tq * (1.0 + t2 * (-1.0 / 6 + t2 * (1.0 / 120 + t2 * (-1.0 / 5040 + t2 * (1.0 / 362880 + t2 * (-1.0 / 39916800 + t2 * (1.0 / 6227020800.0)))))));
      double cs = 1.0 + t2 * (-0.5 + t2 * (1.0 / 24 + t2 * (-1.0 / 720 + t2 * (1.0 / 40320 + t2 * (-1.0 / 3628800 + t2 * (1.0 / 479001600.0 + t2 * (-1.0 / 87178291200.0)))))));
#pragma unroll
      for (int k = 0; k < 3; ++k) { const double s2 = 2.0 * sn * cs, c2 = cs * cs - sn * sn; sn = s2; cs = c2; }
      p.rope[(size_t)idx * 2] = (float)cs; p.rope[(size_t)idx * 2 + 1] = (float)sn;
    }
  }
}
DI void phase_prologue_b(const Params& p, int bid, int nb) {
  const int tid = tidx(), lane = tid & 63, wid = tid >> 6;
  if (bid == 0) for (int i = tid; i < 6144 + 64; i += 512) p.nmax[i] = 0u;
  for (int u = bid; u < 512 + 192; u += nb) {
    if (u < 512) {
      const int row0 = u * 64, b = row0 >> 12;
      f32x4 sh[4], sc[4];
#pragma unroll
      for (int e = 0; e < 4; ++e) { const int col = e * 256 + lane * 4;
        f32x4 a = *(const f32x4*)(p.b_ada + col), c = *(const f32x4*)(p.b_ada + 1024 + col);
        for (int kc = 0; kc < 8; ++kc) { const float* mp = p.modp + ((size_t)(kc * 2 + 0) * 8 + b) * 6144; a += *(const f32x4*)(mp + col); c += *(const f32x4*)(mp + 1024 + col); }
        sh[e] = a; sc[e] = c + 1.f; }
      for (int r = wid; r < 64; r += 8) { const size_t row = (size_t)(row0 + r);
#pragma unroll
        for (int e = 0; e < 4; ++e) { const int col = e * 256 + lane * 4; const f32x4 xv = *(const f32x4*)(p.x + row * DM + col); const f32x4 hv = xv * sc[e] + sh[e];
          st4(p.H + row * DM + col, hv[0], hv[1], hv[2], hv[3]); } }
    } else {
      const int idx = (u - 512) * 512 + tid, j = idx % 6144, lb = idx / 6144, l = lb >> 3, b = lb & 7;
      float a = p.b_ada[l * 6144 + j];
      for (int kc = 0; kc < 8; ++kc) a += p.modp[((size_t)(kc * 2 + l) * 8 + b) * 6144 + j];
      p.mod[(size_t)lb * 6144 + j] = a;
    }
  }
}
DI void phase_ln(const Params& p, const float* g, const float* bta, const float* sh, const float* sc, bool writex, int bid, int nb) {
  const int tid = tidx(), lane = tid & 63, wid = tid >> 6;
  for (int row = bid * 8 + wid; row < NTOK; row += nb * 8) {
    float* xr = p.out + (size_t)row * DM; const int b = row >> 12;
    f32x4 v[4]; float s = 0.f;
#pragma unroll
    for (int e = 0; e < 4; ++e) { v[e] = *(const f32x4*)(xr + e * 256 + lane * 4); s += (v[e][0] + v[e][1]) + (v[e][2] + v[e][3]); }
#pragma unroll
    for (int o = 32; o > 0; o >>= 1) s += __shfl_xor(s, o);
    const float mu = s * (1.f / 1024.f); float q = 0.f;
#pragma unroll
    for (int e = 0; e < 4; ++e) { v[e] -= mu; q += (v[e][0] * v[e][0] + v[e][1] * v[e][1]) + (v[e][2] * v[e][2] + v[e][3] * v[e][3]); }
#pragma unroll
    for (int o = 32; o > 0; o >>= 1) q += __shfl_xor(q, o);
    const float rstd = rsqrtf(q * (1.f / 1024.f) + 1e-5f);
    if (!writex && lane == 0) { f32x2 ms = {mu, rstd}; *(f32x2*)(p.lnstat + (size_t)row * 2) = ms; }
#pragma unroll
    for (int e = 0; e < 4; ++e) { const int col = e * 256 + lane * 4;
      const f32x4 y = v[e] * rstd * *(const f32x4*)(g + col) + *(const f32x4*)(bta + col);
      if (writex) *(f32x4*)(xr + col) = y;
      if (sh) { const f32x4 hv = y * (*(const f32x4*)(sc + b * 6144 + col) + 1.f) + *(const f32x4*)(sh + b * 6144 + col); st4(p.H + (size_t)row * DM + col, hv[0], hv[1], hv[2], hv[3]); } }
  }
}

#define XB_TMO      128
#define XB_XCNT(j)  (256  + 64 * (j))
#define XB_XSUB(j)  (1280 + 64 * (j))
#define XB_XGEN(j)  (2304 + 64 * (j))
#define XB_TOP      3328
#define XB_TOPGEN   3392
#define XCD_BAR_WORDS 3456
#define XB_SPIN_CAP (1u << 18)

__device__ __forceinline__ unsigned xb_ld(unsigned* p)              { return __hip_atomic_load(p, __ATOMIC_RELAXED, __HIP_MEMORY_SCOPE_AGENT); }
__device__ __forceinline__ unsigned xb_add(unsigned* p, unsigned v) { return __hip_atomic_fetch_add(p, v, __ATOMIC_RELAXED, __HIP_MEMORY_SCOPE_AGENT); }
__device__ __forceinline__ unsigned xb_xcc_id() { return (unsigned)__builtin_amdgcn_s_getreg((3 << 11) | 20) & 0xFu; }
#define XB_SPIN(cond, bar) do { unsigned _sp = 0; while (cond) { __builtin_amdgcn_s_sleep(1); \
    if ((++_sp & 255u) == 0u) { if (xb_ld(&(bar)[XB_TMO])) break; if (_sp > XB_SPIN_CAP) { atomicAdd(&(bar)[XB_TMO], 1u); break; } } } } while (0)

struct XcdBarrier {
    unsigned* bar; unsigned x;
    volatile LAS unsigned* st;
};

__device__ __forceinline__ XcdBarrier xcd_barrier_post(unsigned* bar, volatile LAS unsigned* st) {
    XcdBarrier b; b.bar = bar; b.x = xb_xcc_id(); b.st = st;
    if (threadIdx.x == 0) (void)xb_add(&bar[XB_XCNT(b.x)], 1u);
    return b;
}
__device__ __forceinline__ void xcd_barrier_complete(unsigned* bar, unsigned x, unsigned& nloc, unsigned& nx) {
    const unsigned G = gridDim.x * gridDim.y * gridDim.z;
    unsigned sum, cnt, mine, sp = 0u;
    for (;;) {
        sum = 0u; cnt = 0u; mine = 0u;
#pragma unroll
        for (unsigned j = 0; j < 16; ++j) { const unsigned c = xb_ld(&bar[XB_XCNT(j)]); sum += c; cnt += (c > 0u) ? 1u : 0u; mine = (j == x) ? c : mine; }
        if (sum == G) break;
        __builtin_amdgcn_s_sleep(1);
        if ((++sp & 255u) == 0u) { if (xb_ld(&bar[XB_TMO])) break; if (sp > XB_SPIN_CAP) { atomicAdd(&bar[XB_TMO], 1u); break; } }
    }
    nloc = mine > 0u ? mine : 1u; nx = cnt > 0u ? cnt : 1u;
}

__device__ __forceinline__ void xcd_barrier(const XcdBarrier& b) {
    asm volatile("s_waitcnt vmcnt(0)" ::: "memory");
    __syncthreads();
    if (threadIdx.x == 0) {
        unsigned* bar = b.bar;
        __builtin_amdgcn_s_waitcnt(0);
        unsigned nloc = b.st[0], nx = b.st[1];
        if (nloc == 0u) { xcd_barrier_complete(bar, b.x, nloc, nx); b.st[0] = nloc; b.st[1] = nx; }
        const unsigned old = xb_add(&bar[XB_XSUB(b.x)], 1u);
        const unsigned gen = old / nloc;
        if (old + 1u == (gen + 1u) * nloc) {
            __builtin_amdgcn_fence(__ATOMIC_RELEASE, "agent");
            asm volatile("s_waitcnt vmcnt(0)" ::: "memory");
            const unsigned og = xb_add(&bar[XB_TOP], 1u);
            const unsigned tg = og / nx;
            if (og + 1u == (tg + 1u) * nx) xb_add(&bar[XB_TOPGEN], 1u);
            else XB_SPIN(xb_ld(&bar[XB_TOPGEN]) == tg, bar);
            __builtin_amdgcn_fence(__ATOMIC_ACQUIRE, "agent");
            xb_add(&bar[XB_XGEN(b.x)], 1u);
            asm volatile("s_waitcnt vmcnt(0)" ::: "memory");
        } else {
            XB_SPIN(xb_ld(&bar[XB_XGEN(b.x)]) == gen, bar);
            __builtin_amdgcn_fence(__ATOMIC_ACQUIRE, "agent");
            asm volatile("s_waitcnt vmcnt(0)" ::: "memory");
        }
    }
    __syncthreads();
}


constexpr int NPHASE = 2 + 8 * 2;
DI void run_phase(const Params& p, int ph, char* lds, int bid, int nb) {
  if (ph == 0) { phase_prologue_a(lds, p, bid, nb); return; }
  if (ph == 1) { phase_prologue_b(p, bid, nb); return; }
  const int l = (ph - 2) >> 3, sp = (ph - 2) & 7;
  const float* mod = p.mod + (size_t)l * 8 * 6144;
  if (sp == 0) {
    const bf16_t* W = p.wt_in + (size_t)l * 2816 * 1024;
    const pg8::Gemm g{p.H, W, NTOK, 2816, 1024};
    __syncthreads();
    { EpiInProj8 e8{&p, l, lds + EPI8_OFF}; SkipOrder so; so.S.init(NTOK, 2560, nb, bid);
      pg8::gemm_phase<EpiInProj8, SkipOrder, true, true, false>((PG8_LAS unsigned char*)lds, g, so, e8); }
    __syncthreads();
    { EpiVt8 ev{p.vta}; const ColOrder co{2, (nb == 256 ? (bid >= 128 ? bid - 128 : bid + 128) : bid), nb};
      pg8::gemm_phase<EpiVt8, ColOrder, true, true, true>((PG8_LAS unsigned char*)lds, g, co, ev); }
    __syncthreads();
  } else if (sp == 1) {
    EpiMla<0> eq{p}; EpiMla<1> ekv{p};
    gemm_loop<false>(lds, p.proj + C_BCQ, LDP, p.wt_uq + (size_t)l * 512 * 384, 384, 384, bid, nb, 256, 2, 0, eq);
#if PROBE_DUP == 6
    gemm_loop<false>(lds, p.proj + C_BCQ, LDP, p.wt_uq + (size_t)l * 512 * 384, 384, 384, bid, nb, 256, 2, 0, eq);
#endif
    gemm_loop<false>(lds, p.proj + C_BCKV, LDP, p.wt_ukv + (size_t)l * 512 * 256, 256, 256, bid, nb, 128, 1, 0, ekv);
    gemm_loop<true>(lds, p.proj + C_BCKV, LDP, p.wt_ukv + (size_t)l * 512 * 256, 256, 256, (nb == 256 ? (bid >= 128 ? bid - 128 : bid + 128) : bid), nb, 128, 1, 1, ekv);
    for (int t = bid; t < 1536; t += nb) attn_d6_unit(lds, p, l, t);
#if PROBE_DUP == 5
    for (int t = bid; t < 1536; t += nb) attn_d6_unit(lds, p, l, t);
#endif
  } else if (sp == 2) {
    int* su = (int*)(lds + LDS_BYTES - 16);
    for (;;) {
      __syncthreads();
      if (tidx() == 0) *su = (int)atomicAdd(p.nmax + 6144 + l, 1u);
      __syncthreads();
      const int q = *su;
      if (q >= 2048 + 1024) break;
      if (q >= 2048) { dcombine_unit(p, q - 2048); continue; }
      if (q < 256 || q >= 1280) attn_unit<0>(lds, p, l, q < 256 ? 768 + q : 2047 - q);
      else if (q < 768) attn_unit<1>(lds, p, l, q - 256);
      else attn_unit<2>(lds, p, l, q - 768);
    }
  } else if (sp == 3) {
    const EpiResid8 epi{l == 0 ? p.x : p.out, p.out, mod + 2 * 1024, l == 0 ? nullptr : p.lnstat, p.ln_mlp_g + (l - (l > 0)) * 1024, p.ln_mlp_b + (l - (l > 0)) * 1024, lds + EPI8_OFF};
    const pg8::Gemm g{p.Y, p.wt_o + (size_t)l * 1024 * 1024, NTOK, 1024, 1024};
    pg8::StaticOrder S; S.init(NTOK, 1024, nb, bid);
    __syncthreads();
    pg8::gemm_phase<EpiResid8, pg8::StaticOrder, true, true, false>((PG8_LAS unsigned char*)lds, g, S, epi);
    __syncthreads();
  } else if (sp == 4) {
    phase_ln(p, p.ln_attn_g + l * 1024, p.ln_attn_b + l * 1024, mod + 3 * 1024, mod + 4 * 1024, false, bid, nb);
  } else if (sp == 5) {
    const EpiUp8 epi{p.U, lds + EPI8_OFF};
    const pg8::Gemm g{p.H, p.wt_up + (size_t)l * 4096 * 1024, NTOK, 4096, 1024};
    pg8::StaticOrder S; S.init(NTOK, 4096, nb, bid);
    __syncthreads();
    pg8::gemm_phase<EpiUp8, pg8::StaticOrder, true, true, false>((PG8_LAS unsigned char*)lds, g, S, epi);
    __syncthreads();
  } else if (sp == 6) {
    const EpiResid8 epi{p.out, p.out, mod + 5 * 1024, p.lnstat, p.ln_attn_g + l * 1024, p.ln_attn_b + l * 1024, lds + EPI8_OFF};
    const pg8::Gemm g{p.U, p.wt_down + (size_t)l * 1024 * 4096, NTOK, 1024, 4096};
    pg8::StaticOrder S; S.init(NTOK, 1024, nb, bid);
    __syncthreads();
    pg8::gemm_phase<EpiResid8, pg8::StaticOrder, true, true, false>((PG8_LAS unsigned char*)lds, g, S, epi);
    __syncthreads();
  } else {
    const float* nmod = p.mod + (size_t)(l + 1) * 8 * 6144;
    if (bid == 0 && l == 0) for (int i = tidx(); i < 6144; i += 512) p.nmax[i] = 0u;
    phase_ln(p, p.ln_mlp_g + l * 1024, p.ln_mlp_b + l * 1024, l == 0 ? nmod : nullptr, l == 0 ? nmod + 1024 : nullptr, l == 1, bid, nb);
  }
}

#if MULTI_LAUNCH
template <int PH> __global__ void __launch_bounds__(512) k_ph(Params p) {
  __shared__ __attribute__((aligned(16))) char smem[LDS_BYTES];
  run_phase(p, PH, smem, blockIdx.x, gridDim.x);
}
#else
__global__ void __launch_bounds__(512) k_mega(Params p) {
  __shared__ __attribute__((aligned(16))) char smem[LDS_BYTES + 8 * EPI8_IMG + 64];
  cg::grid_group grid = cg::this_grid();
  volatile LAS unsigned* st = (volatile LAS unsigned*)(LAS char*)(smem + LDS_BYTES + 8 * EPI8_IMG);
  if (threadIdx.x < 2) st[threadIdx.x] = 0u;
  __syncthreads();
  const XcdBarrier xb = xcd_barrier_post(p.bar, st);
#define GSYNC_ xcd_barrier(xb)
#define PH_(n) run_phase(p, n, smem, blockIdx.x, gridDim.x)
  PH_(0); grid.sync(); PH_(1); GSYNC_;
  PH_(2); GSYNC_; PH_(3); GSYNC_; PH_(4); GSYNC_; PH_(5); GSYNC_; PH_(6); GSYNC_; PH_(7); GSYNC_; PH_(8); GSYNC_; PH_(9); GSYNC_;
  PH_(10); GSYNC_; PH_(11); GSYNC_; PH_(12); GSYNC_; PH_(13); GSYNC_; PH_(14); GSYNC_; PH_(15); GSYNC_; PH_(16); GSYNC_; PH_(17);
#if PROBE_DUP == 7
  for (int i_ = 0; i_ < 10; ++i_) GSYNC_;
#endif
#undef PH_
}
#endif

extern "C" void kernel_launch(void* const* d_in, const int* in_sizes, int n_in, void* d_out, int out_size, void* d_ws, size_t ws_size, hipStream_t stream) {
  Params p{};
  const float** f = (const float**)&p;
  for (int i = 0; i < 20; ++i) f[i] = (const float*)d_in[i];
  p.out = (float*)d_out;
  char* w = (char*)d_ws; size_t o = 0;
  auto take = [&](size_t bytes) { char* r = w + o; o += (bytes + 255) & ~(size_t)255; return r; };
  p.wt_in = (bf16_t*)take((size_t)2 * 2816 * 1024 * 2);
  p.wt_o = (bf16_t*)take((size_t)2 * 1024 * 1024 * 2);
  p.wt_up = (bf16_t*)take((size_t)2 * 4096 * 1024 * 2);
  p.wt_down = (bf16_t*)take((size_t)2 * 4096 * 1024 * 2);
  p.wt_uq = (bf16_t*)take((size_t)2 * 512 * 384 * 2);
  p.wt_ukv = (bf16_t*)take((size_t)2 * 512 * 256 * 2);
  p.modp = (float*)take((size_t)8 * 2 * 8 * 6144 * 4);
  p.mod = (float*)take((size_t)2 * 8 * 6144 * 4);
  p.rope = (float*)take((size_t)4096 * 16 * 2 * 4);
  p.ssq = (float*)take((size_t)NTOK * 16 * 4);
  p.dlse = (float*)take((size_t)3 * NTOK * 4 * 4);
  p.lnstat = (float*)take((size_t)NTOK * 2 * 4);
  p.bar = (unsigned*)take((size_t)XCD_BAR_WORDS * 4);
  p.nmax = (unsigned*)take((size_t)(6144 + 64) * 4);
  p.H = (bf16_t*)take((size_t)NTOK * 1024 * 2);
  p.dpart = p.H;
  char* R = w + o;
  p.proj = (bf16_t*)take((size_t)NTOK * LDP * 2);
  p.qb = (bf16_t*)take((size_t)NTOK * 384 * 2);
  p.knb = (bf16_t*)take((size_t)NTOK * 256 * 2);
  p.vta = (bf16_t*)take((size_t)8 * 4 * 64 * 4096 * 2);
  p.vtb = (bf16_t*)take((size_t)8 * 4 * 64 * 4096 * 2);
  p.vtc = (bf16_t*)take((size_t)8 * 2 * 64 * 4096 * 2);
  p.Y = (bf16_t*)take((size_t)NTOK * 1024 * 2);
  p.U = (bf16_t*)R;
  static int grid_blocks = 0;
#if MULTI_LAUNCH
  grid_blocks = 256;
#define L_(n) hipLaunchKernelGGL(k_ph<n>, dim3(grid_blocks), dim3(512), 0, stream, p)
  L_(0); L_(1); L_(2); L_(3); L_(4); L_(5); L_(6); L_(7); L_(8); L_(9); L_(10); L_(11); L_(12); L_(13); L_(14); L_(15); L_(16); L_(17);
#undef L_
#else
  if (!grid_blocks) { int dev = 0, cus = 0, per_cu = 0; hipGetDevice(&dev); hipDeviceGetAttribute(&cus, hipDeviceAttributeMultiprocessorCount, dev);
    hipOccupancyMaxActiveBlocksPerMultiprocessor(&per_cu, k_mega, 512, 0); if (per_cu < 1) per_cu = 1; grid_blocks = cus * per_cu; }
  hipMemsetAsync(p.bar, 0, (size_t)XCD_BAR_WORDS * 4, stream);
  void* args[] = {&p};
  hipError_t e = hipLaunchCooperativeKernel((void*)k_mega, dim3(grid_blocks), dim3(512), args, 0, stream);
  if (e != hipSuccess) fprintf(stderr, "cooperative launch failed: %s (grid %d)\n", hipGetErrorString(e), grid_blocks);
#endif
}
```

```cpp
#include <hip/hip_runtime.h>
#include <hip/hip_cooperative_groups.h>
#include <stdint.h>
#include <cstdio>
namespace cg = cooperative_groups;

#ifndef PROBE_DUP
#define PROBE_DUP 0
#endif
#ifndef MULTI_LAUNCH
#define MULTI_LAUNCH 0
#endif

typedef unsigned short bf16_t;
typedef short bf16x8 __attribute__((ext_vector_type(8)));
typedef short s16x4 __attribute__((ext_vector_type(4)));
typedef float f32x16 __attribute__((ext_vector_type(16)));
typedef float f32x4 __attribute__((ext_vector_type(4)));
typedef float f32x2 __attribute__((ext_vector_type(2)));
typedef unsigned u32x4 __attribute__((ext_vector_type(4)));
typedef unsigned u32x2 __attribute__((ext_vector_type(2)));
typedef __bf16 bf2_t __attribute__((ext_vector_type(2)));
#define DI __device__ __forceinline__

constexpr int NTOK = 32768, SEQ = 4096, DM = 1024, LDP = 2816;
constexpr int C_AQ = 0, C_AK = 256, C_BCQ = 768, C_BCKV = 1152, C_CQ = 1408, C_CK = 1664, C_DQ = 1920, C_DK = 2176, C_DV = 2432, C_BKR = 2688;
constexpr float LOG2E = 1.4426950408889634f;
constexpr float SC_A = 0.17677669529663687f * LOG2E;
constexpr float SC_B = 0.10206207261596575f * LOG2E;
constexpr float SC_C = 0.125f * LOG2E;
constexpr float ALPHA = 1.4142135623730951f;
constexpr int LDS_BYTES = 131072;

struct Params {
  const float *x, *c, *w_ada, *b_ada, *w_in, *w_o, *diff_lambda, *diff_subln_g, *mla_q_norm_g, *mla_w_uq, *mla_kv_norm_g, *mla_w_ukv,
      *gqa_q_norm_g, *gqa_k_norm_g, *ln_attn_g, *ln_attn_b, *w_up, *w_down, *ln_mlp_g, *ln_mlp_b;
  float* out;
  bf16_t *wt_in, *wt_o, *wt_up, *wt_down, *wt_uq, *wt_ukv;
  float *modp, *mod, *rope, *ssq, *dlse, *lnstat;
  unsigned* bar;
  unsigned* nmax;
  bf16_t *H, *proj, *qb, *knb, *vta, *vtb, *vtc, *Y, *U, *dpart;
};

DI int tidx() { int t = __builtin_amdgcn_workitem_id_x(); asm volatile("" : "+v"(t)); return t; }
DI unsigned pk2(float a, float b) { f32x2 v = {a, b}; bf2_t r = __builtin_convertvector(v, bf2_t); return __builtin_bit_cast(unsigned, r); }
DI void st4(bf16_t* p, float a, float b, float c, float d) { u32x2 w = {pk2(a, b), pk2(c, d)}; *(u32x2*)p = w; }
DI f32x16 mfma32(bf16x8 a, bf16x8 b, f32x16 c) { return __builtin_amdgcn_mfma_f32_32x32x16_bf16(a, b, c, 0, 0, 0); }
DI f32x16 zero16() { f32x16 z;
#pragma unroll
  for (int i = 0; i < 16; ++i) z[i] = 0.f; return z; }
DI float max3f(float a, float b, float c) { float d; asm("v_max3_f32 %0, %1, %2, %3" : "=v"(d) : "v"(a), "v"(b), "v"(c)); return d; }
DI float bflo(unsigned u) { return __uint_as_float(u << 16); }
DI float bfhi(unsigned u) { return __uint_as_float(u & 0xffff0000u); }

DI void rope32(f32x16& v, const float* __restrict__ rope, int pos, int lh) {
  const float* t = rope + (size_t)pos * 32 + 8 * lh;
#pragma unroll
  for (int g = 0; g < 2; ++g) {
    const f32x4 c0 = *(const f32x4*)(t + g * 16), c1 = *(const f32x4*)(t + g * 16 + 4);
    float x1, x2;
    x1 = v[4 * g + 0]; x2 = v[4 * g + 8];  v[4 * g + 0] = x1 * c0[0] - x2 * c0[1]; v[4 * g + 8]  = x2 * c0[0] + x1 * c0[1];
    x1 = v[4 * g + 1]; x2 = v[4 * g + 9];  v[4 * g + 1] = x1 * c0[2] - x2 * c0[3]; v[4 * g + 9]  = x2 * c0[2] + x1 * c0[3];
    x1 = v[4 * g + 2]; x2 = v[4 * g + 10]; v[4 * g + 2] = x1 * c1[0] - x2 * c1[1]; v[4 * g + 10] = x2 * c1[0] + x1 * c1[1];
    x1 = v[4 * g + 3]; x2 = v[4 * g + 11]; v[4 * g + 3] = x1 * c1[2] - x2 * c1[3]; v[4 * g + 11] = x2 * c1[2] + x1 * c1[3];
  }
}
DI float ssq16(const f32x16& v) { float s = 0.f;
#pragma unroll
  for (int i = 0; i < 16; ++i) s += v[i] * v[i]; return s; }
DI void store_tile(bf16_t* dst, const f32x16& v, int lh, float sc) {
#pragma unroll
  for (int g = 0; g < 4; ++g) st4(dst + 8 * g + 4 * lh, v[4 * g] * sc, v[4 * g + 1] * sc, v[4 * g + 2] * sc, v[4 * g + 3] * sc);
}

DI void store_rows64(char* ldsw, bf16_t* dst, size_t ld, const f32x16& v0, const f32x16& v1, int lane, float sc) {
  const int lr = lane & 31, lh = lane >> 5;
  char* wr = ldsw + lr * 144 + 8 * lh;
#pragma unroll
  for (int g = 0; g < 4; ++g) {
    u32x2 a = {pk2(v0[4 * g] * sc, v0[4 * g + 1] * sc), pk2(v0[4 * g + 2] * sc, v0[4 * g + 3] * sc)};
    u32x2 b = {pk2(v1[4 * g] * sc, v1[4 * g + 1] * sc), pk2(v1[4 * g + 2] * sc, v1[4 * g + 3] * sc)};
    *(u32x2*)(wr + 16 * g) = a; *(u32x2*)(wr + 64 + 16 * g) = b;
  }
  asm volatile("" ::: "memory");
  const int rr = lane >> 3, pc = lane & 7;
#pragma unroll
  for (int it = 0; it < 4; ++it) {
    const u32x4 d = *(const u32x4*)(ldsw + (it * 8 + rr) * 144 + pc * 16);
    *(u32x4*)(dst + (size_t)(it * 8 + rr) * ld + pc * 8) = d;
  }
  asm volatile("" ::: "memory");
}

#define LAS __attribute__((address_space(3)))
constexpr int G_STAGE = 65536, G_BOFF = 32768;
template <bool VM>
DI void g_compute(f32x16 (&acc)[4][2], const LAS char* buf, int aofs, int bofs, int o0) {
#pragma unroll
  for (int ks = 0; ks < 4; ++ks) {
    const int oo = o0 ^ (ks << 5);
    bf16x8 a[4], b[2];
#pragma unroll
    for (int i = 0; i < 4; ++i) a[i] = *(const LAS bf16x8*)(buf + aofs + i * 4096 + oo);
#pragma unroll
    for (int j = 0; j < 2; ++j) b[j] = *(const LAS bf16x8*)(buf + bofs + j * 4096 + oo);
#pragma unroll
    for (int i = 0; i < 4; ++i)
#pragma unroll
      for (int j = 0; j < 2; ++j) acc[i][j] = VM ? mfma32(a[i], b[j], acc[i][j]) : mfma32(b[j], a[i], acc[i][j]);
  }
}
constexpr int EPI_LDS = G_STAGE;
template <bool VM, class Epi>
DI void gemm_loop(char* lds_g, const bf16_t* __restrict__ A, int lda, const bf16_t* __restrict__ Bt, int ldb, int K, int first, int stride, int total, int npn, int pn0, const Epi& epi) {
  if (first >= total) return;
  LAS char* lds = (LAS char*)lds_g;
  const int tid = tidx(), lane = tid & 63, wid = __builtin_amdgcn_readfirstlane(tid >> 6), wm = wid >> 2, wn = wid & 3, lr = lane & 31, lh = lane >> 5;
  const int grow = lane >> 3, gc = ((lane & 7) ^ ((wid & 1) * 4 + (lane >> 4))) * 8;
  const size_t a64 = (size_t)64 * lda, b64 = (size_t)64 * ldb;
  const bf16_t* gA; const bf16_t* gB;
  auto issue = [&](int kt, int stage) __attribute__((always_inline)) {
    LAS char* sb = lds + stage * G_STAGE + wid * 1024;
#pragma unroll
    for (int e = 0; e < 4; ++e) __builtin_amdgcn_global_load_lds((const unsigned*)(gA + e * a64 + kt * 64), (LAS unsigned*)(sb + e * 8192), 16, 0, 0);
#pragma unroll
    for (int e = 0; e < 4; ++e) __builtin_amdgcn_global_load_lds((const unsigned*)(gB + e * b64 + kt * 64), (LAS unsigned*)(sb + G_BOFF + e * 8192), 16, 0, 0);
  };
  int nk = K >> 6;
  asm volatile("" : "+s"(nk));
  const int swz = (lr >> 1) & 7, o0 = (lh ^ swz) * 16;
  const int aofs = (wm * 128 + lr) * 128, bofs = G_BOFF + (wn * 64 + lr) * 128;
  const bool xmap = (stride == 256) && (npn >= 2) && (total == 128 * npn);
  const int sn = npn < 8 ? npn : 8, sm = 32 / sn, xn = npn / sn, Rm = sm * (8 / xn), xx = first & 7, kk = first >> 3;
  auto tile_of = [&](int it, int& pm_, int& pn_) __attribute__((always_inline)) -> bool {
    if (xmap) { pm_ = it * Rm + (xx / xn) * sm + kk / sn; pn_ = pn0 + (xx % xn) * sn + kk % sn; return pm_ < 128; }
    const int t_ = first + it * stride; pm_ = t_ / npn; pn_ = pn0 + t_ % npn; return t_ < total;
  };
  int it = 0, pm, pn;
  tile_of(0, pm, pn);
  gA = A + (size_t)(pm * 256 + wid * 8 + grow) * lda + gc; gB = Bt + (size_t)(pn * 256 + wid * 8 + grow) * ldb + gc;
  __syncthreads();
  issue(0, 0);
  for (;;) {
    f32x16 acc[4][2];
#pragma unroll
    for (int i = 0; i < 4; ++i)
#pragma unroll
      for (int j = 0; j < 2; ++j) acc[i][j] = zero16();
    asm volatile("s_waitcnt vmcnt(0)" ::: "memory"); __builtin_amdgcn_s_barrier(); asm volatile("" ::: "memory");
    for (int kt = 0; kt < nk; ++kt) {
      if (kt + 1 < nk) issue(kt + 1, (kt + 1) & 1);
      g_compute<VM>(acc, lds + (kt & 1) * G_STAGE, aofs, bofs, o0);
      asm volatile("s_waitcnt vmcnt(0)" ::: "memory");
      __builtin_amdgcn_s_barrier(); asm volatile("" ::: "memory");
    }
    int pm2 = pm, pn2 = pn; const bool has_next = tile_of(it + 1, pm2, pn2);
    if (has_next) { gA = A + (size_t)(pm2 * 256 + wid * 8 + grow) * lda + gc; gB = Bt + (size_t)(pn2 * 256 + wid * 8 + grow) * ldb + gc; issue(0, 0); }
    epi.template run<VM>(acc, pm, pn, wm, wn, lr, lh, lds_g);
    if (!has_next) break;
    ++it; pm = pm2; pn = pn2;
  }
  __syncthreads();
}

struct EpiInProj {
  const Params& p; int layer;
  template <bool VM> DI void run(f32x16 (&acc)[4][2], int pm, int pn, int wm, int wn, int lr, int lh, char* lds) const {
    const int hu = pn * 4 + wn, tok0 = pm * 256 + wm * 128;
    if constexpr (VM) {
      bf16_t* vt = p.vta; const int head = hu - 8, nh = 4;
      const int b = tok0 >> 12, s0 = tok0 & 4095;
#pragma unroll
      for (int i = 0; i < 4; ++i)
#pragma unroll
        for (int j = 0; j < 2; ++j) {
          bf16_t* dst = vt + ((size_t)((b * nh + head) * 64 + j * 32 + lr)) * 4096 + s0 + i * 32 + 4 * lh;
#pragma unroll
          for (int g = 0; g < 4; ++g) st4(dst + 8 * g, acc[i][j][4 * g], acc[i][j][4 * g + 1], acc[i][j][4 * g + 2], acc[i][j][4 * g + 3]);
        }
    } else {
      if (hu == 43) return;
      if (hu == 28 || hu == 29) {
        const int b = tok0 >> 12, s0 = tok0 & 4095;
#pragma unroll
        for (int i = 0; i < 4; ++i)
#pragma unroll
          for (int j = 0; j < 2; ++j)
#pragma unroll
            for (int r = 0; r < 16; ++r) { const int d = j * 32 + (r & 3) + 8 * (r >> 2) + 4 * lh;
              p.vtc[((size_t)((b * 2 + hu - 28) * 64 + d)) * 4096 + s0 + i * 32 + lr] = (bf16_t)(pk2(acc[i][j][r], 0.f) & 0xffffu); }
        return;
      }
#pragma unroll
      for (int i = 0; i < 4; ++i) {
        const int token = tok0 + i * 32 + lr, s = token & 4095;
        f32x16 v0 = acc[i][0], v1 = acc[i][1];
        float sc = 1.f;
        if (hu < 4) sc = SC_A;
        if (hu < 8) {
          float n0 = ssq16(v0), n1 = ssq16(v1);
          n0 += __shfl_xor(n0, 32); n1 += __shfl_xor(n1, 32);
#pragma unroll
          for (int o = 16; o > 0; o >>= 1) { n0 = fmaxf(n0, __shfl_xor(n0, o)); n1 = fmaxf(n1, __shfl_xor(n1, o)); }
          if (lr == 0 && lh == 0) {
            const int bb = token >> 12;
            if (hu < 4) { const int idx = 4096 + ((bb * 4 + hu) * 2) * 32 + (s >> 7);
              atomicMax(p.nmax + idx, __float_as_uint(n0 * SC_A * SC_A)); atomicMax(p.nmax + idx + 32, __float_as_uint(n1 * SC_A * SC_A)); }
            else { const int idx = ((bb * 4 + hu - 4) * 2) * 64 + (s >> 6);
              atomicMax(p.nmax + idx, __float_as_uint(n0)); atomicMax(p.nmax + idx + 64, __float_as_uint(n1)); }
          }
        }
        else if (hu >= 12 && hu < 22) {
          float q = ssq16(v0) + ssq16(v1); q += __shfl_xor(q, 32);
          if (lh == 0) p.ssq[(size_t)token * 16 + (hu - 12)] = q;
        } else if (hu >= 22 && hu < 28) {
          float q = ssq16(v0) + ssq16(v1); q += __shfl_xor(q, 32);
          const float rinv = rsqrtf(q * (1.f / 64.f) + 1e-6f);
          const float* g = (hu < 26 ? p.gqa_q_norm_g : p.gqa_k_norm_g) + layer * 64 + 4 * lh;
#pragma unroll
          for (int gg = 0; gg < 4; ++gg) { const f32x4 g0 = *(const f32x4*)(g + 8 * gg), g1 = *(const f32x4*)(g + 32 + 8 * gg);
#pragma unroll
            for (int e = 0; e < 4; ++e) { v0[4 * gg + e] *= rinv * g0[e]; v1[4 * gg + e] *= rinv * g1[e]; } }
          rope32(v0, p.rope, s >> 6, lh); rope32(v1, p.rope, s & 63, lh);
          if (hu < 26) sc = SC_C;
        } else if (hu >= 30 && hu < 34) sc = SC_C;
        else if (hu == 42) rope32(v0, p.rope, s, lh);
        store_rows64(lds + EPI_LDS + (wm * 4 + wn) * 4608, p.proj + (size_t)(tok0 + i * 32) * LDP + hu * 64, LDP, v0, v1, lh * 32 + lr, sc);
      }
    }
  }
};

template <int KIND> struct EpiMla {
  const Params& p;
  DI bool vm(int hu) const { return KIND == 1 && hu >= 4; }
  template <bool VM> DI void run(f32x16 (&acc)[4][2], int pm, int pn, int wm, int wn, int lr, int lh, char* lds) const {
    float* sR = (float*)(lds + EPI_LDS + 8 * 4608);
    const int tid = tidx();
    if (tid < 256) { const float* q = p.ssq + (size_t)(pm * 256 + tid) * 16; float s;
      if (KIND == 0) { s = ((q[0] + q[1]) + (q[2] + q[3])) + (q[4] + q[5]); s = rsqrtf(s * (1.f / 384.f) + 1e-6f); }
      else { s = (q[6] + q[7]) + (q[8] + q[9]); s = rsqrtf(s * (1.f / 256.f) + 1e-6f); }
      sR[tid] = s; }
    __syncthreads();
    const int hu = pn * 4 + wn, tok0 = pm * 256 + wm * 128;
    if constexpr (VM) {
      const int b = tok0 >> 12, s0 = tok0 & 4095, head = hu - 4;
#pragma unroll
      for (int i = 0; i < 4; ++i)
#pragma unroll
        for (int j = 0; j < 2; ++j) {
          bf16_t* dst = p.vtb + ((size_t)((b * 4 + head) * 64 + j * 32 + lr)) * 4096 + s0 + i * 32 + 4 * lh;
#pragma unroll
          for (int g = 0; g < 4; ++g) { const f32x4 r = *(const f32x4*)(sR + wm * 128 + i * 32 + 8 * g + 4 * lh);
            st4(dst + 8 * g, acc[i][j][4 * g] * r[0], acc[i][j][4 * g + 1] * r[1], acc[i][j][4 * g + 2] * r[2], acc[i][j][4 * g + 3] * r[3]); }
        }
    } else {
#pragma unroll
      for (int i = 0; i < 4; ++i) {
        const int token = tok0 + i * 32 + lr, s = token & 4095;
        const float rinv = sR[wm * 128 + i * 32 + lr];
        f32x16 v0 = acc[i][0] * rinv, v1 = acc[i][1] * rinv;
        if (KIND == 0) {
          if (hu >= 6) continue;
          if (hu >= 4) { rope32(v0, p.rope, s, lh); rope32(v1, p.rope, s, lh); }
          store_rows64(lds + EPI_LDS + (wm * 4 + wn) * 4608, p.qb + (size_t)(tok0 + i * 32) * 384 + hu * 64, 384, v0, v1, lh * 32 + lr, SC_B);
        } else {
          store_rows64(lds + EPI_LDS + (wm * 4 + wn) * 4608, p.knb + (size_t)(tok0 + i * 32) * 256 + hu * 64, 256, v0, v1, lh * 32 + lr, 1.f);
        }
      }
    }
    __syncthreads();
  }
};

struct EpiResid {
  const float* xsrc; float* out; const float* gate;
  const float* stat; const float* lng; const float* lnb;
  template <bool VM> DI void run(f32x16 (&acc)[4][2], int pm, int pn, int wm, int wn, int lr, int lh, char* lds) const {
    const int tok0 = pm * 256 + wm * 128, b = tok0 >> 12, lane = lh * 32 + lr, rr = lane >> 3, pc = lane & 7;
    char* img = lds + EPI_LDS + (wm * 4 + wn) * 4608;
#pragma unroll
    for (int j = 0; j < 2; ++j) {
      const int col = pn * 256 + wn * 64 + j * 32 + pc * 4;
      const f32x4 gt = *(const f32x4*)(gate + b * 6144 + col);
      f32x4 lg = {1.f, 1.f, 1.f, 1.f}, lb = {0.f, 0.f, 0.f, 0.f};
      if (stat) { lg = *(const f32x4*)(lng + col); lb = *(const f32x4*)(lnb + col); }
#pragma unroll
      for (int i = 0; i < 4; ++i) {
#pragma unroll
        for (int g = 0; g < 4; ++g) { const f32x4 v = {acc[i][j][4 * g], acc[i][j][4 * g + 1], acc[i][j][4 * g + 2], acc[i][j][4 * g + 3]}; *(f32x4*)(img + lr * 144 + (8 * g + 4 * lh) * 4) = v; }
        asm volatile("" ::: "memory");
#pragma unroll
        for (int it = 0; it < 4; ++it) {
          const f32x4 a = *(const f32x4*)(img + (it * 8 + rr) * 144 + pc * 16);
          const size_t off = (size_t)(tok0 + i * 32 + it * 8 + rr) * DM + col;
          f32x4 xi = *(const f32x4*)(xsrc + off);
          if (stat) { const f32x2 ms = *(const f32x2*)(stat + (size_t)(tok0 + i * 32 + it * 8 + rr) * 2); xi = (xi - ms[0]) * ms[1] * lg + lb; }
          *(f32x4*)(out + off) = ALPHA * xi + gt * a;
        }
        asm volatile("" ::: "memory");
      }
    }
  }
};
struct EpiUp {
  bf16_t* U;
  template <bool VM> DI void run(f32x16 (&acc)[4][2], int pm, int pn, int wm, int wn, int lr, int lh, char* lds) const {
    const int tok0 = pm * 256 + wm * 128;
#pragma unroll
    for (int i = 0; i < 4; ++i) {
      f32x16 v0, v1;
#pragma unroll
      for (int r = 0; r < 16; ++r) { const float a = fmaxf(acc[i][0][r], 0.f), b = fmaxf(acc[i][1][r], 0.f); v0[r] = a * a; v1[r] = b * b; }
      store_rows64(lds + EPI_LDS + (wm * 4 + wn) * 4608, U + (size_t)(tok0 + i * 32) * 4096 + pn * 256 + wn * 64, 4096, v0, v1, lh * 32 + lr, 1.f);
    }
  }
};

template <int MODE>
DI void attn_unit(char* lds, const Params& p, int layer, int u) {
  constexpr int NKS = MODE == 0 ? 2 : (MODE == 1 ? 6 : 4);
  constexpr int KST = MODE == 1 ? 208 : 144;
  constexpr int VOFF = 64 * KST, VST = 144, BUFSZ = VOFF + 64 * VST;
  const int tid = tidx(), lane = tid & 63, wid = tid >> 6, lr = lane & 31, lh = lane >> 5;
  int b, h, q0, dl = 1, rho = 0, br = 0, L = SEQ, comp = 0;
  if (MODE == 0) { h = u >> 8; b = (u >> 5) & 7; q0 = (u & 31) * 128; comp = wid >> 2; }
  else if (MODE == 1 || MODE == 2) { h = (u >> 4) & 3; b = u >> 6; q0 = (u & 15) * 256; }
  else { br = u >> 9; const int r = u & 511; b = r >> 6; h = (r >> 4) & 3; const int xx = r & 15; dl = 1 << (2 * br); rho = xx & (dl - 1); q0 = (xx >> (2 * br)) * 256; L = SEQ >> (2 * br); }
  const int qrow = (MODE == 0) ? q0 + (wid & 3) * 32 + lr : q0 + wid * 32 + lr;
  const int token = (MODE == 3) ? b * SEQ + rho + dl * qrow : b * SEQ + qrow;
  int NT = (MODE == 3) ? 6 : 64, tlo = 0;
  if (MODE == 0) {
    const float sl2 = exp2f(-(float)(2 * h + 1)) * LOG2E;
    const unsigned* km = p.nmax + ((b * 4 + h) * 2) * 64; const unsigned* qm = p.nmax + 4096 + ((b * 4 + h) * 2) * 32 + (q0 >> 7);
    const float q0n = 1.02f * sqrtf(__uint_as_float(qm[0])), q1n = 1.02f * sqrtf(__uint_as_float(qm[32]));
    const int td = q0 >> 6;
    const float kd0 = sqrtf(fmaxf(__uint_as_float(km[td]), __uint_as_float(km[td + 1]))), kd1 = sqrtf(fmaxf(__uint_as_float(km[64 + td]), __uint_as_float(km[64 + td + 1])));
    const float thr0 = -q0n * kd0 - 40.f, thr1 = -q1n * kd1 - 40.f;
    int lo = td, hi = td + 1;
    for (int T = 0; T < 64; ++T) {
      const int dmin = (T < td) ? (q0 - (64 * T + 63)) : ((T > td + 1) ? (64 * T - (q0 + 127)) : 0);
      const float pen = sl2 * (float)dmin;
      const bool need = (q0n * sqrtf(__uint_as_float(km[T])) - pen >= thr0) || (q1n * sqrtf(__uint_as_float(km[64 + T])) - pen >= thr1);
      if (need) { lo = T < lo ? T : lo; hi = T > hi ? T : hi; }
    }
    tlo = __builtin_amdgcn_readfirstlane(lo); NT = __builtin_amdgcn_readfirstlane(hi - lo + 1);
  }
  bf16x8 qf[NKS];
  if constexpr (MODE == 0) { const bf16_t* q = p.proj + (size_t)token * LDP + C_AQ + h * 64 + comp * 32 + lh * 8;
#pragma unroll
    for (int ks = 0; ks < NKS; ++ks) qf[ks] = *(const bf16x8*)(q + ks * 16); }
  else if constexpr (MODE == 1) { const bf16_t* q = p.qb + (size_t)token * 384 + lh * 8;
#pragma unroll
    for (int ks = 0; ks < 4; ++ks) qf[ks] = *(const bf16x8*)(q + h * 64 + ks * 16);
#pragma unroll
    for (int ks = 4; ks < 6; ++ks) qf[ks] = *(const bf16x8*)(q + 256 + h * 32 + (ks - 4) * 16); }
  else { const bf16_t* q = p.proj + (size_t)token * LDP + (MODE == 2 ? C_CQ : C_DQ) + h * 64 + lh * 8;
#pragma unroll
    for (int ks = 0; ks < NKS; ++ks) qf[ks] = *(const bf16x8*)(q + ks * 16); }
  const bf16_t* vtbase = (MODE == 0) ? p.vta + (size_t)((b * 4 + h) * 64) * 4096 : (MODE == 1) ? p.vtb + (size_t)((b * 4 + h) * 64) * 4096 : p.vtc + (size_t)((b * 2 + (h >> 1)) * 64) * 4096;
  float slope2 = 0.f;
  if (MODE == 0) slope2 = exp2f(-(float)(2 * h + 1)) * LOG2E;
  if (MODE == 3) slope2 = exp2f(-(float)(2 * h + 2)) * LOG2E * (float)dl;
  const int srow = tid >> 3, sc = tid & 7;
  u32x4 kr0, kr2, vr0;
  kr2 = (u32x4){0u, 0u, 0u, 0u};
  auto prefetch = [&](int t) __attribute__((always_inline)) {
    const int key0 = (MODE == 3) ? q0 - 64 + 64 * t : 64 * (tlo + t);
    if (MODE != 3) {
      const size_t tokk = (size_t)(b * SEQ + key0 + srow);
      const bf16_t* kp = (MODE == 0) ? p.proj + tokk * LDP + C_AK + h * 64 : (MODE == 1) ? p.knb + tokk * 256 + h * 64 : p.proj + tokk * LDP + C_CK + (h >> 1) * 64;
      kr0 = *(const u32x4*)(kp + sc * 8);
      if (MODE == 1) kr2 = *(const u32x4*)(p.proj + tokk * LDP + C_BKR + (sc & 3) * 8);
      vr0 = *(const u32x4*)(vtbase + (size_t)srow * 4096 + key0 + sc * 8);
    } else {
      int v = key0 + srow; v = v < 0 ? 0 : (v >= L ? L - 1 : v);
      const bf16_t* kp = p.proj + (size_t)(b * SEQ + rho + dl * v) * LDP + h * 64;
      kr0 = *(const u32x4*)(kp + C_DK + sc * 8);
      vr0 = *(const u32x4*)(kp + C_DV + sc * 8);
    }
  };
  auto stage = [&](char* buf) __attribute__((always_inline)) {
    char* kd = buf + srow * KST + sc * 16;
    *(u32x4*)kd = kr0;
    if (MODE == 1) { if (sc < 4) *(u32x4*)(buf + srow * KST + 128 + sc * 16) = kr2; }
    if (MODE != 3) { *(u32x4*)(buf + VOFF + srow * VST + sc * 16) = vr0; }
    else {
      bf16_t* vd = (bf16_t*)(buf + VOFF) + srow;
#pragma unroll
      for (int e = 0; e < 4; ++e) { vd[(sc * 8 + 2 * e) * 72] = (bf16_t)(vr0[e] & 0xffffu); vd[(sc * 8 + 2 * e + 1) * 72] = (bf16_t)(vr0[e] >> 16); }
    }
  };
  f32x16 O0 = zero16(), O1 = zero16();
  float m = -1e30f, l = 0.f;
  f32x16 T0 = zero16(), T1 = zero16();
  if (MODE == 0) {
#pragma unroll
    for (int r = 0; r < 16; ++r) { const float cc = (float)((r & 3) + 8 * (r >> 2)); T0[r] = slope2 * cc; T1[r] = slope2 * (cc + 32.f); }
  }
  const int qlo = q0 + (wid & 3) * 32;
  prefetch(0);
  __syncthreads();
  stage(lds);
  prefetch(1);
  __syncthreads();
  for (int t = 0; t < NT; ++t) {
    char* cur = lds + (t & 1) * BUFSZ;
    if (t + 1 < NT) { stage(lds + ((t + 1) & 1) * BUFSZ); if (t + 2 < NT) prefetch(t + 2); }
    const int key0 = (MODE == 3) ? q0 - 64 + 64 * t : 64 * (tlo + t);
    const bool act = (MODE != 3) || (t >= (wid >> 1) && t <= (wid >> 1) + 2);
    if (act) {
      f32x16 S0 = zero16(), S1 = zero16();
      const char* kb = cur + lr * KST + (MODE == 0 ? comp * 64 : 0) + lh * 16;
#pragma unroll
      for (int ks = 0; ks < NKS; ++ks) {
        const bf16x8 k0 = *(const bf16x8*)(kb + ks * 32), k1 = *(const bf16x8*)(kb + 32 * KST + ks * 32);
        S0 = mfma32(k0, qf[ks], S0); S1 = mfma32(k1, qf[ks], S1);
      }
      float aoff = 0.f;
      if (MODE == 0) {
        const float dbase = (float)(key0 + 4 * lh - qrow);
        if (key0 > qlo + 31) { S0 = S0 - T0; S1 = S1 - T1; aoff = -slope2 * dbase; }
        else if (key0 + 63 < qlo) { S0 = S0 + T0; S1 = S1 + T1; aoff = slope2 * dbase; }
        else {
#pragma unroll
          for (int r = 0; r < 16; ++r) { const float cc = (float)((r & 3) + 8 * (r >> 2));
            S0[r] = fmaf(-slope2, fabsf(dbase + cc), S0[r]); S1[r] = fmaf(-slope2, fabsf(dbase + cc + 32.f), S1[r]); }
        }
      }
      if (MODE == 3) {
        const int rel0 = key0 + 4 * lh - qrow;
#pragma unroll
        for (int r = 0; r < 16; ++r) { const int cc = (r & 3) + 8 * (r >> 2);
          { const int rel = rel0 + cc, v = qrow + rel; const bool ok = (rel >= -64) && (rel <= 64) && (v >= 0) && (v < L); S0[r] = ok ? fmaf(-slope2, fabsf((float)rel), S0[r]) : -1e30f; }
          { const int rel = rel0 + cc + 32, v = qrow + rel; const bool ok = (rel >= -64) && (rel <= 64) && (v >= 0) && (v < L); S1[r] = ok ? fmaf(-slope2, fabsf((float)rel), S1[r]) : -1e30f; } }
      }
      float mx = fmaxf(S0[0], S1[0]);
#pragma unroll
      for (int r = 1; r < 16; ++r) mx = max3f(mx, S0[r], S1[r]);
      mx += aoff;
      if (__any(mx > m + 8.f)) {
        mx = fmaxf(mx, __shfl_xor(mx, 32));
        const float mnew = fmaxf(m, mx);
        const float al = __builtin_amdgcn_exp2f(m - mnew); l *= al; O0 *= al; O1 *= al;
        m = mnew;
      }
      { const f32x2 nm = {aoff - m, aoff - m};
#pragma unroll
        for (int r = 0; r < 8; ++r) {
          f32x2 a = {S0[2 * r], S0[2 * r + 1]}, b = {S1[2 * r], S1[2 * r + 1]};
          asm("v_pk_add_f32 %0, %1, %2" : "=v"(a) : "v"(a), "v"(nm));
          asm("v_pk_add_f32 %0, %1, %2" : "=v"(b) : "v"(b), "v"(nm));
          S0[2 * r] = a[0]; S0[2 * r + 1] = a[1]; S1[2 * r] = b[0]; S1[2 * r + 1] = b[1];
        } }
#pragma unroll
      for (int r = 0; r < 16; ++r) { S0[r] = __builtin_amdgcn_exp2f(S0[r]); S1[r] = __builtin_amdgcn_exp2f(S1[r]); }
      const f32x16 SS = S0 + S1;
      float ps = 0.f;
#pragma unroll
      for (int r = 0; r < 16; ++r) ps += SS[r];
      l += ps;
      bf16x8 pf[4];
#pragma unroll
      for (int s = 0; s < 4; ++s) {
        u32x4 w;
        if (s < 2) { w[0] = pk2(S0[8 * s], S0[8 * s + 1]); w[1] = pk2(S0[8 * s + 2], S0[8 * s + 3]); w[2] = pk2(S0[8 * s + 4], S0[8 * s + 5]); w[3] = pk2(S0[8 * s + 6], S0[8 * s + 7]); }
        else { const int s2 = s - 2; w[0] = pk2(S1[8 * s2], S1[8 * s2 + 1]); w[1] = pk2(S1[8 * s2 + 2], S1[8 * s2 + 3]); w[2] = pk2(S1[8 * s2 + 4], S1[8 * s2 + 5]); w[3] = pk2(S1[8 * s2 + 6], S1[8 * s2 + 7]); }
        pf[s] = __builtin_bit_cast(bf16x8, w);
      }
      const char* vb = cur + VOFF + lr * VST + lh * 8;
#pragma unroll
      for (int s = 0; s < 4; ++s) {
        { const s16x4 lo = *(const s16x4*)(vb + s * 32), hi = *(const s16x4*)(vb + s * 32 + 16);
          O0 = mfma32(__builtin_shufflevector(lo, hi, 0, 1, 2, 3, 4, 5, 6, 7), pf[s], O0); }
        { const s16x4 lo = *(const s16x4*)(vb + 32 * VST + s * 32), hi = *(const s16x4*)(vb + 32 * VST + s * 32 + 16);
          O1 = mfma32(__builtin_shufflevector(lo, hi, 0, 1, 2, 3, 4, 5, 6, 7), pf[s], O1); }
      }
    }
    __syncthreads();
  }
  l += __shfl_xor(l, 32);
  const float inv = 1.f / l;
  O0 *= inv; O1 *= inv;
  if (MODE == 1 || MODE == 2) {
    bf16_t* dst = p.Y + (size_t)token * DM + (MODE == 1 ? 256 : 512) + h * 64;
    store_tile(dst, O0, lh, 1.f); store_tile(dst + 32, O1, lh, 1.f);
  } else if (MODE == 3) {
    bf16_t* dst = p.dpart + ((size_t)br * NTOK + token) * 256 + h * 64;
    store_tile(dst, O0, lh, 1.f); store_tile(dst + 32, O1, lh, 1.f);
    if (lh == 0) p.dlse[((size_t)br * NTOK + token) * 4 + h] = m + log2f(l);
  } else {
    float* xb = (float*)lds + (wid & 3) * 2048 + lane;
    if (comp == 1) {
#pragma unroll
      for (int r = 0; r < 16; ++r) { xb[r * 64] = O0[r]; xb[(16 + r) * 64] = O1[r]; }
    }
    __syncthreads();
    if (comp == 0) {
      const float* dlm = p.diff_lambda + layer * 128;
      float s1 = 0.f, s2 = 0.f;
      for (int i = 0; i < 32; ++i) { s1 += dlm[i] * dlm[32 + i]; s2 += dlm[64 + i] * dlm[96 + i]; }
      const float lambda_init = 0.8f - 0.6f * expf(-0.3f * (float)layer);
      const float lam = expf(s1) - expf(s2) + lambda_init;
      float q = 0.f;
#pragma unroll
      for (int r = 0; r < 16; ++r) { O0[r] -= lam * xb[r * 64]; O1[r] -= lam * xb[(16 + r) * 64]; q += O0[r] * O0[r] + O1[r] * O1[r]; }
      q += __shfl_xor(q, 32);
      const float rinv = rsqrtf(q * (1.f / 64.f) + 1e-6f) * (1.f - lambda_init);
      const float* g = p.diff_subln_g + layer * 64 + 4 * lh;
#pragma unroll
      for (int gg = 0; gg < 4; ++gg) { const f32x4 g0 = *(const f32x4*)(g + 8 * gg), g1 = *(const f32x4*)(g + 32 + 8 * gg);
#pragma unroll
        for (int e = 0; e < 4; ++e) { O0[4 * gg + e] *= rinv * g0[e]; O1[4 * gg + e] *= rinv * g1[e]; } }
      bf16_t* dst = p.Y + (size_t)token * DM + h * 64;
      store_tile(dst, O0, lh, 1.f); store_tile(dst + 32, O1, lh, 1.f);
    }
  }
}

DI void attn_d6_loop(char* lds, const Params& p, int layer, int first, int stride, int total) {
  constexpr int KST = 144, VOFF = 384 * KST;
  const int tid = tidx(), lane = tid & 63, wid = tid >> 6, lr = lane & 31, lh = lane >> 5;
  const int srow = tid >> 3, sc = tid & 7;
  u32x4 kr[6], vr[6];
  auto load_unit = [&](int un) __attribute__((always_inline)) {
    const int br_ = un >> 9, r_ = un & 511, b_ = r_ >> 6, h_ = (r_ >> 4) & 3, xx_ = r_ & 15, dl_ = 1 << (2 * br_), rho_ = xx_ & (dl_ - 1), q0_ = (xx_ >> (2 * br_)) * 256, L_ = SEQ >> (2 * br_);
#pragma unroll
    for (int c = 0; c < 6; ++c) {
      int v = q0_ - 64 + 64 * c + srow; v = v < 0 ? 0 : (v >= L_ ? L_ - 1 : v);
      const bf16_t* kp = p.proj + (size_t)(b_ * SEQ + rho_ + dl_ * v) * LDP + h_ * 64 + sc * 8;
      kr[c] = *(const u32x4*)(kp + C_DK); vr[c] = *(const u32x4*)(kp + C_DV);
    }
  };
  if (first < total) load_unit(first);
  for (int u = first; u < total; u += stride) {
  const int br = u >> 9, r = u & 511, b = r >> 6, h = (r >> 4) & 3, xx = r & 15, dl = 1 << (2 * br), rho = xx & (dl - 1), q0 = (xx >> (2 * br)) * 256, L = SEQ >> (2 * br);
  const int qrow = q0 + wid * 32 + lr, token = b * SEQ + rho + dl * qrow;
  bf16x8 qf[4];
  { const bf16_t* q = p.proj + (size_t)token * LDP + C_DQ + h * 64 + lh * 8;
#pragma unroll
    for (int ks = 0; ks < 4; ++ks) qf[ks] = *(const bf16x8*)(q + ks * 16); }
  const float slope2 = exp2f(-(float)(2 * h + 2)) * LOG2E * (float)dl;
  __syncthreads();
#pragma unroll
  for (int c = 0; c < 6; ++c) {
    *(u32x4*)(lds + (64 * c + srow) * KST + sc * 16) = kr[c];
    *(u32x4*)(lds + VOFF + (64 * c + srow) * KST + sc * 16) = vr[c];
  }
  __syncthreads();
  if (u + stride < total) load_unit(u + stride);
  f32x16 O0 = zero16(), O1 = zero16();
  float m = -1e30f, l = 0.f;
#pragma unroll 1
  for (int c = wid >> 1; c <= (wid >> 1) + 2; ++c) {
#pragma unroll
    for (int hf = 0; hf < 2; ++hf) {
      const bool skip = (hf == 0) ? ((wid & 1) && c == (wid >> 1)) : (!(wid & 1) && c == (wid >> 1) + 2);
      if (skip) continue;
      const int key0 = q0 - 64 + 64 * c + 32 * hf;
      f32x16 S = zero16();
      const char* kb = lds + (64 * c + 32 * hf + lr) * KST + lh * 16;
#pragma unroll
      for (int ks = 0; ks < 4; ++ks) S = mfma32(*(const bf16x8*)(kb + ks * 32), qf[ks], S);
      const int rel0 = key0 + 4 * lh - qrow;
#pragma unroll
      for (int r2 = 0; r2 < 16; ++r2) { const int rel = rel0 + (r2 & 3) + 8 * (r2 >> 2), v = qrow + rel;
        const bool ok = (rel >= -64) && (rel <= 64) && (v >= 0) && (v < L); S[r2] = ok ? fmaf(-slope2, fabsf((float)rel), S[r2]) : -1e30f; }
      float mx = S[0];
#pragma unroll
      for (int r2 = 1; r2 < 15; r2 += 2) mx = max3f(mx, S[r2], S[r2 + 1]);
      mx = fmaxf(mx, S[15]);
      if (__any(mx > m + 8.f)) {
        mx = fmaxf(mx, __shfl_xor(mx, 32));
        const float mnew = fmaxf(m, mx);
        const float al = __builtin_amdgcn_exp2f(m - mnew); l *= al; O0 *= al; O1 *= al;
        m = mnew;
      }
      float ps = 0.f;
#pragma unroll
      for (int r2 = 0; r2 < 16; ++r2) { S[r2] = __builtin_amdgcn_exp2f(S[r2] - m); ps += S[r2]; }
      l += ps;
      bf16x8 pf[2];
#pragma unroll
      for (int s2 = 0; s2 < 2; ++s2) { u32x4 w; w[0] = pk2(S[8 * s2], S[8 * s2 + 1]); w[1] = pk2(S[8 * s2 + 2], S[8 * s2 + 3]); w[2] = pk2(S[8 * s2 + 4], S[8 * s2 + 5]); w[3] = pk2(S[8 * s2 + 6], S[8 * s2 + 7]);
        pf[s2] = __builtin_bit_cast(bf16x8, w); }
      { const int g = lane >> 4, i16 = lane & 15;
        const unsigned vbase = (unsigned)(size_t)(lds + VOFF) + (unsigned)((64 * c + 32 * hf + 4 * (g >> 1) + (i16 >> 2)) * KST + ((g & 1) * 16 + 4 * (i16 & 3)) * 2);
#pragma unroll
        for (int s2 = 0; s2 < 2; ++s2) {
          s16x4 l0, h0, l1, h1;
          const unsigned a0 = vbase + (unsigned)(16 * s2 * KST), a1 = a0 + 8u * KST, a2 = a0 + 64u, a3 = a1 + 64u;
          asm volatile("ds_read_b64_tr_b16 %0, %4\n\tds_read_b64_tr_b16 %1, %5\n\tds_read_b64_tr_b16 %2, %6\n\tds_read_b64_tr_b16 %3, %7\n\ts_waitcnt lgkmcnt(0)"
                       : "=&v"(l0), "=&v"(h0), "=&v"(l1), "=&v"(h1) : "v"(a0), "v"(a1), "v"(a2), "v"(a3) : "memory");
          O0 = mfma32(__builtin_shufflevector(l0, h0, 0, 1, 2, 3, 4, 5, 6, 7), pf[s2], O0);
          O1 = mfma32(__builtin_shufflevector(l1, h1, 0, 1, 2, 3, 4, 5, 6, 7), pf[s2], O1);
        } }
    }
  }
  l += __shfl_xor(l, 32);
  const float inv = 1.f / l;
  O0 *= inv; O1 *= inv;
  bf16_t* dst = p.dpart + ((size_t)br * NTOK + token) * 256 + h * 64;
  store_tile(dst, O0, lh, 1.f); store_tile(dst + 32, O1, lh, 1.f);
  if (lh == 0) p.dlse[((size_t)br * NTOK + token) * 4 + h] = m + log2f(l);
  }
}

DI void dcombine_unit(const Params& p, int u) {
#pragma unroll
  for (int e = 0; e < 2; ++e) {
    const int idx = u * 1024 + e * 512 + tidx(), token = idx >> 5, rem = idx & 31, h = rem >> 3, dc = rem & 7;
    float ls[3], mx = -1e30f;
#pragma unroll
    for (int n = 0; n < 3; ++n) { ls[n] = p.dlse[((size_t)n * NTOK + token) * 4 + h]; mx = fmaxf(mx, ls[n]); }
    float w[3], ws = 0.f;
#pragma unroll
    for (int n = 0; n < 3; ++n) { w[n] = exp2f(ls[n] - mx); ws += w[n]; }
    const float inv = 1.f / ws;
    float o[8];
#pragma unroll
    for (int i = 0; i < 8; ++i) o[i] = 0.f;
#pragma unroll
    for (int n = 0; n < 3; ++n) { const u32x4 d = *(const u32x4*)(p.dpart + ((size_t)n * NTOK + token) * 256 + h * 64 + dc * 8); const float wn = w[n] * inv;
#pragma unroll
      for (int i = 0; i < 4; ++i) { o[2 * i] += wn * bflo(d[i]); o[2 * i + 1] += wn * bfhi(d[i]); } }
    u32x4 r = {pk2(o[0], o[1]), pk2(o[2], o[3]), pk2(o[4], o[5]), pk2(o[6], o[7])};
    *(u32x4*)(p.Y + (size_t)token * DM + 768 + h * 64 + dc * 8) = r;
  }
}


namespace pg8 {
#define PG8_LAS __attribute__((address_space(3)))
typedef unsigned short bf16_t;
typedef short bf16x8 __attribute__((ext_vector_type(8)));
typedef float f32x4 __attribute__((ext_vector_type(4)));
typedef unsigned u32x4 __attribute__((ext_vector_type(4)));
constexpr int BM = 256, BK = 64, HALF = 128, HTB = HALF * BK * 2  , STAGE_BYTES = 8 * HTB, NXCD = 8, WGM = 8;

__host__ __device__ __forceinline__ int lds_byte(int r, int c) { const int st = (r >> 4) * 2 + (c >> 5), rr = r & 15, cc = c & 31, ob = rr * 64 + cc * 2; return st * 1024 + (ob ^ (((ob >> 9) & 1) << 5)); }
__host__ __device__ __forceinline__ void stage_rc(int b, int& R, int& C) { const int st = b / 1024, sb = b % 1024, swz = sb ^ (((sb >> 9) & 1) << 5); R = (st >> 1) * 16 + swz / 64; C = (st & 1) * 32 + (swz % 64) / 2; }
__host__ __device__ __forceinline__ int perm32(int rho) { const int n = rho >> 4, i = rho & 15; return 8 * (i >> 2) + 4 * n + (i & 3); }

struct Unit { int pm, pn; };
struct Gemm { const bf16_t* A; const bf16_t* Bt; int M, N, K; };

struct StaticOrder {
    int nM, nN, nwg, G, c;
    __host__ __device__ void init(int M, int N, int G_, int c_) { nM = M / BM; nN = N / BM; nwg = nM * nN; G = G_; c = c_; }
    __host__ __device__ bool next(int i, Unit& u) const {
        const long L = (long)i * G + c; if (L >= nwg) return false;
        int wgid = (int)L; { const int q = nwg / NXCD, r = nwg % NXCD, xcd = wgid % NXCD, off = wgid / NXCD; wgid = (xcd < r ? xcd * (q + 1) : r * (q + 1) + (xcd - r) * q) + off; }
        const int nig = WGM * nN, gid = wgid / nig, fm = gid * WGM, gsz = (nM - fm) < WGM ? (nM - fm) : WGM;
        u.pm = fm + ((wgid % nig) % gsz); u.pn = (wgid % nig) / gsz; return true;
    }
    __device__ __forceinline__ void a_ready(const Unit&) const {}
    __device__ __forceinline__ void done(const Unit&) const {}
};

typedef float f32x2 __attribute__((ext_vector_type(2)));
template <class Epi, class Sched, bool ALIGN_EPI = false, bool SP2 = false, bool VM = false>
__device__ __forceinline__ void gemm_phase(PG8_LAS unsigned char* lds, const Gemm g, const Sched& S, const Epi& E) {
    const int tid = tidx(), wid = __builtin_amdgcn_readfirstlane(tid >> 6), lane = tid & 63, wr = wid >> 2, wc = wid & 3, fr = lane & 15, fq = lane >> 4;
    const int K = g.K, nt = K / BK;
    unsigned voffA[2], voffB[2];
#pragma unroll
    for (int i = 0; i < 2; ++i) { int R, C; stage_rc(tid * 16 + i * 8192, R, C); const int Rb = Epi::PERM ? ((R & ~31) + perm32(R & 31)) : R;
        voffA[i] = (unsigned)(R * K + C) * 2u; voffB[i] = (unsigned)(Rb * K + C) * 2u; }
    const size_t kstep = (size_t)(BK * 2);
    const size_t hstep = (size_t)HALF * K * 2;
    const size_t tstep = 2 * hstep;
    const unsigned ldsw = (unsigned)wid * 1024u;
    const int aoff = lds_byte(wr * 64 + fr, fq * 8), boff = lds_byte(wc * 32 + fr, fq * 8);
#define PG8_SA(b, h) (((b) * 2 + (h)) * HTB)
#define PG8_SB(b, h) ((4 + (b) * 2 + (h)) * HTB)
#define PG8_STAGE(bufoff, gbase, voff) do { _Pragma("unroll") for (int _i = 0; _i < 2; ++_i) \
        __builtin_amdgcn_global_load_lds((const unsigned*)((const char*)(gbase) + (voff)[_i]), (PG8_LAS unsigned*)(lds + (bufoff) + ldsw + _i * 8192), 16, 0, 0); } while (0)
#define PG8_LDA(dst, b, h) do { _Pragma("unroll") for (int m = 0; m < 4; ++m) _Pragma("unroll") for (int k = 0; k < 2; ++k) dst[m][k] = *(const PG8_LAS bf16x8*)(lds + PG8_SA(b, h) + aoff + m * 2048 + k * 1024); } while (0)
#define PG8_LDB(dst, b, h) do { _Pragma("unroll") for (int n = 0; n < 2; ++n) _Pragma("unroll") for (int k = 0; k < 2; ++k) dst[n][k] = *(const PG8_LAS bf16x8*)(lds + PG8_SB(b, h) + boff + n * 2048 + k * 1024); } while (0)
#define PG8_MMA(ai, bj, At, Bt) do { __builtin_amdgcn_s_setprio(1); _Pragma("unroll") for (int m = 0; m < 4; ++m) _Pragma("unroll") for (int n = 0; n < 2; ++n) _Pragma("unroll") for (int k = 0; k < 2; ++k) \
        acc[ai][bj][m][n] = VM ? __builtin_amdgcn_mfma_f32_16x16x32_bf16(At[m][k], Bt[n][k], acc[ai][bj][m][n], 0, 0, 0) : __builtin_amdgcn_mfma_f32_16x16x32_bf16(Bt[n][k], At[m][k], acc[ai][bj][m][n], 0, 0, 0); __builtin_amdgcn_s_setprio(0); } while (0)
#define PG8_WAIT_V(n) asm volatile("s_waitcnt vmcnt(" #n ")" ::: "memory")
#define PG8_WAIT_L(n) asm volatile("s_waitcnt lgkmcnt(" #n ")" ::: "memory")
#define PG8_BAR __builtin_amdgcn_s_barrier()
#define PG8_SCHED __builtin_amdgcn_sched_barrier(0)
    Unit cur, nxt; int ui = 0;
    if (!S.next(0, cur)) return;
    f32x4 acc[2][2][4][2];
#pragma unroll
    for (int a = 0; a < 2; ++a)
#pragma unroll
        for (int b = 0; b < 2; ++b)
#pragma unroll
            for (int m = 0; m < 4; ++m)
#pragma unroll
                for (int n = 0; n < 2; ++n) acc[a][b][m][n] = (f32x4){0.f, 0.f, 0.f, 0.f};
    bf16x8 At[4][2], B0[2][2], B1[2][2];
    const char* cA = (const char*)g.A + (size_t)cur.pm * tstep; const char* cB = (const char*)g.Bt + (size_t)cur.pn * tstep;
    S.a_ready(cur);
    if constexpr (SP2) {
        PG8_STAGE(PG8_SB(0, 0), cB, voffB); PG8_STAGE(PG8_SB(0, 1), cB + hstep, voffB); PG8_STAGE(PG8_SA(0, 0), cA, voffA); PG8_STAGE(PG8_SA(0, 1), cA + hstep, voffA);
        if (wr == 1) PG8_BAR;
        PG8_WAIT_V(2); PG8_BAR;
        PG8_STAGE(PG8_SB(1, 0), cB + kstep, voffB); PG8_STAGE(PG8_SA(1, 0), cA + kstep, voffA); PG8_STAGE(PG8_SB(1, 1), cB + hstep + kstep, voffB);
        PG8_WAIT_V(6); PG8_BAR;
    } else {
        PG8_STAGE(PG8_SB(0, 0), cB, voffB); PG8_STAGE(PG8_SA(0, 0), cA, voffA); PG8_STAGE(PG8_SB(0, 1), cB + hstep, voffB); PG8_STAGE(PG8_SA(0, 1), cA + hstep, voffA);
        if (wr == 1) PG8_BAR;
        PG8_WAIT_V(4); PG8_BAR;
        PG8_STAGE(PG8_SB(1, 0), cB + kstep, voffB); PG8_STAGE(PG8_SA(1, 0), cA + kstep, voffA); PG8_STAGE(PG8_SB(1, 1), cB + hstep + kstep, voffB);
        PG8_WAIT_V(6); PG8_BAR;
    }
    for (;;) {
        const bool has_next = S.next(ui + 1, nxt);
        const char* nA = has_next ? (const char*)g.A + (size_t)nxt.pm * tstep : cA; const char* nB = has_next ? (const char*)g.Bt + (size_t)nxt.pn * tstep : cB;
        for (int t = 0; t < nt; t += 2) {
            const bool last = (t == nt - 2);
            const char* a1 = cA + (size_t)(t + 1) * kstep;
            const char* a2 = last ? nA : cA + (size_t)(t + 2) * kstep; const char* b2 = last ? nB : cB + (size_t)(t + 2) * kstep;
            const char* a3 = a2 + kstep; const char* b3 = b2 + kstep;
            if (last && has_next) S.a_ready(nxt);
            if constexpr (SP2) {
            PG8_LDB(B0, 0, 0); PG8_LDB(B1, 0, 1); PG8_SCHED; PG8_LDA(At, 0, 0); PG8_STAGE(PG8_SA(1, 1), a1 + hstep, voffA);
            PG8_WAIT_V(8); PG8_WAIT_L(0); PG8_BAR; PG8_MMA(0, 0, At, B0); PG8_MMA(0, 1, At, B1); PG8_BAR; PG8_SCHED;
            PG8_LDA(At, 0, 1); PG8_STAGE(PG8_SB(0, 0), b2, voffB); PG8_STAGE(PG8_SB(0, 1), b2 + hstep, voffB); PG8_STAGE(PG8_SA(0, 0), a2, voffA);
            PG8_WAIT_V(8); PG8_WAIT_L(0); PG8_BAR; PG8_MMA(1, 0, At, B0); PG8_MMA(1, 1, At, B1); PG8_BAR; PG8_SCHED;
            PG8_LDB(B0, 1, 0); PG8_LDB(B1, 1, 1); PG8_SCHED; PG8_LDA(At, 1, 0); PG8_STAGE(PG8_SA(0, 1), a2 + hstep, voffA);
            PG8_WAIT_V(8); PG8_WAIT_L(0); PG8_BAR; PG8_MMA(0, 0, At, B0); PG8_MMA(0, 1, At, B1); PG8_BAR; PG8_SCHED;
            PG8_LDA(At, 1, 1); PG8_STAGE(PG8_SB(1, 0), b3, voffB); PG8_STAGE(PG8_SB(1, 1), b3 + hstep, voffB); PG8_STAGE(PG8_SA(1, 0), a3, voffA);
            PG8_WAIT_V(8); PG8_WAIT_L(0); PG8_BAR; PG8_MMA(1, 0, At, B0); PG8_MMA(1, 1, At, B1); PG8_BAR; PG8_SCHED;
            } else {
            PG8_LDB(B0, 0, 0); PG8_SCHED; PG8_LDA(At, 0, 0); PG8_STAGE(PG8_SA(1, 1), a1 + hstep, voffA);
            PG8_WAIT_L(8); PG8_BAR; PG8_WAIT_L(0); PG8_MMA(0, 0, At, B0); PG8_BAR; PG8_SCHED;
            PG8_LDB(B1, 0, 1); PG8_STAGE(PG8_SB(0, 0), b2, voffB);
            PG8_BAR; PG8_WAIT_L(0); PG8_MMA(0, 1, At, B1); PG8_BAR;
            PG8_LDA(At, 0, 1); PG8_STAGE(PG8_SA(0, 0), a2, voffA);
            PG8_BAR; PG8_WAIT_L(0); PG8_MMA(1, 0, At, B0); PG8_BAR; PG8_SCHED;
            PG8_STAGE(PG8_SB(0, 1), b2 + hstep, voffB);
            PG8_WAIT_V(6); PG8_BAR; PG8_MMA(1, 1, At, B1); PG8_BAR;
            PG8_LDB(B0, 1, 0); PG8_SCHED; PG8_LDA(At, 1, 0); PG8_STAGE(PG8_SA(0, 1), a2 + hstep, voffA);
            PG8_WAIT_L(8); PG8_BAR; PG8_WAIT_L(0); PG8_MMA(0, 0, At, B0); PG8_BAR; PG8_SCHED;
            PG8_LDB(B1, 1, 1); PG8_STAGE(PG8_SB(1, 0), b3, voffB);
            PG8_BAR; PG8_WAIT_L(0); PG8_MMA(0, 1, At, B1); PG8_BAR;
            PG8_LDA(At, 1, 1); PG8_STAGE(PG8_SA(1, 0), a3, voffA);
            PG8_BAR; PG8_WAIT_L(0); PG8_MMA(1, 0, At, B0); PG8_BAR; PG8_SCHED;
            PG8_STAGE(PG8_SB(1, 1), b3 + hstep, voffB);
            PG8_WAIT_V(6); PG8_BAR; PG8_MMA(1, 1, At, B1); PG8_BAR;
            }
        }
        if constexpr (ALIGN_EPI) { if (wr == 0) PG8_BAR; }
        if constexpr (!Epi::AFTER_DRAIN) { E(acc, cur, wr, wc, fr, fq); S.done(cur); }
        if (!has_next) break;
#pragma unroll
        for (int a = 0; a < 2; ++a)
#pragma unroll
            for (int b = 0; b < 2; ++b)
#pragma unroll
                for (int m = 0; m < 4; ++m)
#pragma unroll
                    for (int n = 0; n < 2; ++n) acc[a][b][m][n] = (f32x4){0.f, 0.f, 0.f, 0.f};
        cur = nxt; cA = nA; cB = nB; ++ui;
        if constexpr (ALIGN_EPI) { if (wr == 1) PG8_BAR; }
    }
    PG8_WAIT_V(0);
    if constexpr (!ALIGN_EPI) { if (wr == 0) PG8_BAR; }
    PG8_BAR;
    if constexpr (Epi::AFTER_DRAIN) { E.fused(acc, cur, wr, wc, fr, fq, lds, wid, lane); S.done(cur); }
#undef PG8_SA
#undef PG8_SB
#undef PG8_STAGE
#undef PG8_LDA
#undef PG8_LDB
#undef PG8_MMA
#undef PG8_WAIT_V
#undef PG8_WAIT_L
#undef PG8_BAR
#undef PG8_SCHED
}
}

constexpr int EPI8_OFF = 131072, EPI8_IMG = 2304;
DI int logical_col(int n) { return (n & ~255) | (((n >> 5) & 3) << 6) | (((n >> 7) & 1) << 5) | (n & 31); }
DI void store16x64_bf16(char* img, bf16_t* dst, size_t ld, const f32x4 (&v)[2][2], int fr, int fq, float sc) {
  char* wp = img + fr * 144 + fq * 8;
#pragma unroll
  for (int bj = 0; bj < 2; ++bj)
#pragma unroll
    for (int n = 0; n < 2; ++n) { u32x2 w = {pk2(v[bj][n][0] * sc, v[bj][n][1] * sc), pk2(v[bj][n][2] * sc, v[bj][n][3] * sc)}; *(u32x2*)(wp + bj * 64 + n * 32) = w; }
  asm volatile("" ::: "memory");
  const int lane = fq * 16 + fr, rr = lane >> 2, pc = (lane & 3) * 2;
#pragma unroll
  for (int k = 0; k < 2; ++k) { const u32x4 d = *(const u32x4*)(img + rr * 144 + (pc + k) * 16); *(u32x4*)(dst + (size_t)rr * ld + (pc + k) * 8) = d; }
  asm volatile("" ::: "memory");
}
DI void rope_grp(f32x4& lo, f32x4& hi, const float* __restrict__ rope, int pos, int fq) {
  const float* t = rope + (size_t)pos * 32 + 8 * fq;
  const f32x4 c0 = *(const f32x4*)t, c1 = *(const f32x4*)(t + 4);
  float x1, x2;
  x1 = lo[0]; x2 = hi[0]; lo[0] = x1 * c0[0] - x2 * c0[1]; hi[0] = x2 * c0[0] + x1 * c0[1];
  x1 = lo[1]; x2 = hi[1]; lo[1] = x1 * c0[2] - x2 * c0[3]; hi[1] = x2 * c0[2] + x1 * c0[3];
  x1 = lo[2]; x2 = hi[2]; lo[2] = x1 * c1[0] - x2 * c1[1]; hi[2] = x2 * c1[0] + x1 * c1[1];
  x1 = lo[3]; x2 = hi[3]; lo[3] = x1 * c1[2] - x2 * c1[3]; hi[3] = x2 * c1[2] + x1 * c1[3];
}
DI float ssq4(const f32x4& a) { return (a[0] * a[0] + a[1] * a[1]) + (a[2] * a[2] + a[3] * a[3]); }

struct EpiInProj8 {
  static constexpr bool PERM = false, AFTER_DRAIN = false;
  const Params* pp; int layer; char* img0;
  DI void operator()(const pg8::f32x4 (&acc)[2][2][4][2], const pg8::Unit& u, int wr, int wc, int fr, int fq) const {
    asm volatile("" : "+v"(fr), "+v"(fq));
    const Params& p = *pp;
    const int hu = u.pn * 4 + wc;
    if (hu == 43) return;
    char* img = img0 + (wr * 4 + wc) * EPI8_IMG;
    const int bb = (u.pm * 256) >> 12;
#pragma unroll
    for (int ai = 0; ai < 2; ++ai) {
      float nm0 = 0.f, nm1 = 0.f;
#pragma unroll
      for (int m = 0; m < 4; ++m) {
        __builtin_amdgcn_sched_barrier(0);
        const int token = u.pm * 256 + 128 * ai + 64 * wr + 16 * m + fr, s = token & 4095;
        f32x4 v[2][2];
#pragma unroll
        for (int bj = 0; bj < 2; ++bj)
#pragma unroll
          for (int n = 0; n < 2; ++n) v[bj][n] = acc[ai][bj][m][n];
        if (hu == 28 || hu == 29) {
#pragma unroll
          for (int bj = 0; bj < 2; ++bj)
#pragma unroll
            for (int n = 0; n < 2; ++n)
#pragma unroll
              for (int e = 0; e < 4; ++e) { const int d = 32 * bj + 16 * n + 4 * fq + e;
                p.vtc[((size_t)((bb * 2 + hu - 28) * 64 + d)) * 4096 + s] = (bf16_t)(pk2(v[bj][n][e], 0.f) & 0xffffu); }
          continue;
        }
        float sc = 1.f;
        if (hu < 4) sc = SC_A;
        if (hu < 8) {
          float n0 = ssq4(v[0][0]) + ssq4(v[0][1]), n1 = ssq4(v[1][0]) + ssq4(v[1][1]);
          n0 += __shfl_xor(n0, 16); n0 += __shfl_xor(n0, 32); n1 += __shfl_xor(n1, 16); n1 += __shfl_xor(n1, 32);
          nm0 = fmaxf(nm0, n0); nm1 = fmaxf(nm1, n1);
        } else if (hu >= 12 && hu < 22) {
          float q = (ssq4(v[0][0]) + ssq4(v[0][1])) + (ssq4(v[1][0]) + ssq4(v[1][1]));
          q += __shfl_xor(q, 16); q += __shfl_xor(q, 32);
          if (fq == 0) p.ssq[(size_t)token * 16 + (hu - 12)] = q;
        } else if (hu >= 22 && hu < 28) {
          float q = (ssq4(v[0][0]) + ssq4(v[0][1])) + (ssq4(v[1][0]) + ssq4(v[1][1]));
          q += __shfl_xor(q, 16); q += __shfl_xor(q, 32);
          const float rinv = rsqrtf(q * (1.f / 64.f) + 1e-6f);
          const float* g = (hu < 26 ? p.gqa_q_norm_g : p.gqa_k_norm_g) + layer * 64 + 4 * fq;
#pragma unroll
          for (int bj = 0; bj < 2; ++bj)
#pragma unroll
            for (int n = 0; n < 2; ++n) v[bj][n] = v[bj][n] * rinv * *(const f32x4*)(g + 32 * bj + 16 * n);
          rope_grp(v[0][0], v[0][1], p.rope, s >> 6, fq); rope_grp(v[1][0], v[1][1], p.rope, s & 63, fq);
          if (hu < 26) sc = SC_C;
        } else if (hu >= 30 && hu < 34) sc = SC_C;
        else if (hu == 42) rope_grp(v[0][0], v[0][1], p.rope, s, fq);
        store16x64_bf16(img, p.proj + (size_t)(token - fr) * LDP + hu * 64, LDP, v, fr, fq, sc);
      }
      if (hu < 8) {
#pragma unroll
        for (int o = 8; o > 0; o >>= 1) { nm0 = fmaxf(nm0, __shfl_xor(nm0, o)); nm1 = fmaxf(nm1, __shfl_xor(nm1, o)); }
        if (fr == 0 && fq == 0) {
          const int s0 = (u.pm * 256 + 128 * ai + 64 * wr) & 4095;
          if (hu < 4) { const int idx = 4096 + ((bb * 4 + hu) * 2) * 32 + (s0 >> 7);
            atomicMax(p.nmax + idx, __float_as_uint(nm0 * SC_A * SC_A)); atomicMax(p.nmax + idx + 32, __float_as_uint(nm1 * SC_A * SC_A)); }
          else { const int idx = ((bb * 4 + hu - 4) * 2) * 64 + (s0 >> 6);
            atomicMax(p.nmax + idx, __float_as_uint(nm0)); atomicMax(p.nmax + idx + 64, __float_as_uint(nm1)); }
        }
      }
    }
  }
};
struct EpiVt8 {
  static constexpr bool PERM = false, AFTER_DRAIN = false;
  bf16_t* vt;
  DI void operator()(const pg8::f32x4 (&acc)[2][2][4][2], const pg8::Unit& u, int wr, int wc, int fr, int fq) const {
    const int bb = (u.pm * 256) >> 12;
#pragma unroll
    for (int ai = 0; ai < 2; ++ai)
#pragma unroll
      for (int m = 0; m < 4; ++m) { const int s = (u.pm * 256 + 128 * ai + 64 * wr + 16 * m + 4 * fq) & 4095;
#pragma unroll
        for (int bj = 0; bj < 2; ++bj)
#pragma unroll
          for (int n = 0; n < 2; ++n) { const int d = 32 * bj + 16 * n + fr; const pg8::f32x4 a = acc[ai][bj][m][n];
            st4(vt + ((size_t)((bb * 4 + wc) * 64 + d)) * 4096 + s, a[0], a[1], a[2], a[3]); } }
  }
};
struct EpiUp8 {
  static constexpr bool PERM = false, AFTER_DRAIN = false;
  bf16_t* U; char* img0;
  DI void operator()(const pg8::f32x4 (&acc)[2][2][4][2], const pg8::Unit& u, int wr, int wc, int fr, int fq) const {
    char* img = img0 + (wr * 4 + wc) * EPI8_IMG;
#pragma unroll
    for (int ai = 0; ai < 2; ++ai)
#pragma unroll
      for (int m = 0; m < 4; ++m) {
        f32x4 v[2][2];
#pragma unroll
        for (int bj = 0; bj < 2; ++bj)
#pragma unroll
          for (int n = 0; n < 2; ++n) { const pg8::f32x4 a = acc[ai][bj][m][n];
#pragma unroll
            for (int e = 0; e < 4; ++e) { const float t = fmaxf(a[e], 0.f); v[bj][n][e] = t * t; } }
        store16x64_bf16(img, U + (size_t)(u.pm * 256 + 128 * ai + 64 * wr + 16 * m) * 4096 + u.pn * 256 + wc * 64, 4096, v, fr, fq, 1.f);
      }
  }
};
struct EpiResid8 {
  static constexpr bool PERM = false, AFTER_DRAIN = false;
  const float* xsrc; float* out; const float* gate; const float* stat; const float* lng; const float* lnb; char* img0;
  DI void operator()(const pg8::f32x4 (&acc)[2][2][4][2], const pg8::Unit& u, int wr, int wc, int fr, int fq) const {
    char* img = img0 + (wr * 4 + wc) * EPI8_IMG;
    const int lane = fq * 16 + fr, rr = lane >> 2, pc = (lane & 3) * 2, bb = (u.pm * 256) >> 12;
#pragma unroll
    for (int bj = 0; bj < 2; ++bj) {
      const int col = u.pn * 256 + wc * 64 + 32 * bj + pc * 4;
      const f32x4 gt0 = *(const f32x4*)(gate + bb * 6144 + col), gt1 = *(const f32x4*)(gate + bb * 6144 + col + 4);
      f32x4 lg0 = {1.f, 1.f, 1.f, 1.f}, lg1 = lg0, lb0 = {0.f, 0.f, 0.f, 0.f}, lb1 = lb0;
      if (stat) { lg0 = *(const f32x4*)(lng + col); lg1 = *(const f32x4*)(lng + col + 4); lb0 = *(const f32x4*)(lnb + col); lb1 = *(const f32x4*)(lnb + col + 4); }
#pragma unroll
      for (int ai = 0; ai < 2; ++ai)
#pragma unroll
      for (int mh = 0; mh < 2; ++mh) {
        f32x4 xa[2][2]; f32x2 ms[2];
#pragma unroll
        for (int k = 0; k < 2; ++k) {
          const int row = u.pm * 256 + 128 * ai + 64 * wr + 16 * (2 * mh + k) + rr;
          const size_t off = (size_t)row * DM + col;
          xa[k][0] = *(const f32x4*)(xsrc + off); xa[k][1] = *(const f32x4*)(xsrc + off + 4);
          ms[k] = stat ? *(const f32x2*)(stat + (size_t)row * 2) : (f32x2){0.f, 1.f};
        }
#pragma unroll
        for (int k = 0; k < 2; ++k) {
          const int m = 2 * mh + k;
          *(f32x4*)(img + fr * 144 + fq * 16) = acc[ai][bj][m][0]; *(f32x4*)(img + fr * 144 + 64 + fq * 16) = acc[ai][bj][m][1];
          asm volatile("" ::: "memory");
          const f32x4 a0 = *(const f32x4*)(img + rr * 144 + pc * 16), a1 = *(const f32x4*)(img + rr * 144 + pc * 16 + 16);
          const int row = u.pm * 256 + 128 * ai + 64 * wr + 16 * m + rr;
          const size_t off = (size_t)row * DM + col;
          f32x4 x0 = xa[k][0], x1 = xa[k][1];
          if (stat) { x0 = (x0 - ms[k][0]) * ms[k][1] * lg0 + lb0; x1 = (x1 - ms[k][0]) * ms[k][1] * lg1 + lb1; }
          *(f32x4*)(out + off) = ALPHA * x0 + gt0 * a0; *(f32x4*)(out + off + 4) = ALPHA * x1 + gt1 * a1;
          asm volatile("" ::: "memory");
        }
      }
    }
  }
};
struct SkipOrder { pg8::StaticOrder S;
  __device__ bool next(int i, pg8::Unit& u) const { if (!S.next(i, u)) return false; if (u.pn >= 2) u.pn += 1; return true; }
  __device__ __forceinline__ void a_ready(const pg8::Unit&) const {} __device__ __forceinline__ void done(const pg8::Unit&) const {} };
struct ColOrder { int pn, first, G;
  __device__ bool next(int i, pg8::Unit& u) const { const int t = first + i * G; if (t >= 128) return false; u.pm = t; u.pn = pn; return true; }
  __device__ __forceinline__ void a_ready(const pg8::Unit&) const {} __device__ __forceinline__ void done(const pg8::Unit&) const {} };

DI int colmap(int kind, int n) {
  if (kind == 0 || kind == 3) n = logical_col(n);
  if (kind == 0) { if (n < 1408) return n; if (n < 2688) return n + 32; if (n < 2720) return n - 2688 + 1408; return -1; }
  if (kind == 1) { if (n >= 384) return -1; if (n < 256) return (n >> 6) * 96 + (n & 63); const int mm = n - 256; return (mm >> 5) * 96 + 64 + (mm & 31); }
  if (kind == 2) { if (n < 256) return (n >> 6) * 128 + (n & 63); const int mm = n - 256; return (mm >> 6) * 128 + 64 + (mm & 63); }
  return n;
}
DI void transpose_tile(char* lds, const float* __restrict__ in, int ldin, const float* __restrict__ scale, bf16_t* __restrict__ out, int Kdim, int kind, int nt, int kt) {
  float* tile = (float*)lds;
  const int tid = tidx(), n0 = nt * 64, k0 = kt * 64;
  {
    const int nl = (tid & 15) * 4, col = colmap(kind, n0 + nl);
#pragma unroll
    for (int rr = 0; rr < 2; ++rr) { const int kl = rr * 32 + (tid >> 4);
      f32x4 v = {0.f, 0.f, 0.f, 0.f}; if (col >= 0) { v = *(const f32x4*)(in + (size_t)(k0 + kl) * ldin + col); if (scale) v *= scale[k0 + kl]; }
      float* t = tile + kl * 65 + nl; t[0] = v[0]; t[1] = v[1]; t[2] = v[2]; t[3] = v[3]; }
  }
  __syncthreads();
  {
    const int nl = tid >> 3, kc = (tid & 7) * 8;
    float v[8];
#pragma unroll
    for (int e = 0; e < 8; ++e) v[e] = tile[(kc + e) * 65 + nl];
    bf16_t* dst = out + (size_t)(n0 + nl) * Kdim + k0 + kc;
    u32x4 w0 = {pk2(v[0], v[1]), pk2(v[2], v[3]), pk2(v[4], v[5]), pk2(v[6], v[7])};
    *(u32x4*)dst = w0;
  }
  __syncthreads();
}

constexpr int TR_PER_LAYER = 704 + 256 + 1024 + 1024 + 48 + 32;
DI void phase_prologue_a(char* lds, const Params& p, int bid, int nb) {
  const int total = 2 * TR_PER_LAYER + 192 + 128;
  for (int u = bid; u < total; u += nb) {
    if (u < 2 * TR_PER_LAYER) {
      const int l = u / TR_PER_LAYER; int r = u % TR_PER_LAYER;
      if (r < 704) { transpose_tile(lds, p.w_in + (size_t)l * 1024 * 2720, 2720, nullptr, p.wt_in + (size_t)l * 2816 * 1024, 1024, 0, r >> 4, r & 15); continue; } r -= 704;
      if (r < 256) { transpose_tile(lds, p.w_o + (size_t)l * 1024 * 1024, 1024, nullptr, p.wt_o + (size_t)l * 1024 * 1024, 1024, 3, r >> 4, r & 15); continue; } r -= 256;
      if (r < 1024) { transpose_tile(lds, p.w_up + (size_t)l * 1024 * 4096, 4096, nullptr, p.wt_up + (size_t)l * 4096 * 1024, 1024, 3, r >> 4, r & 15); continue; } r -= 1024;
      if (r < 1024) { transpose_tile(lds, p.w_down + (size_t)l * 4096 * 1024, 1024, nullptr, p.wt_down + (size_t)l * 1024 * 4096, 4096, 3, r >> 6, r & 63); continue; } r -= 1024;
      if (r < 48) { transpose_tile(lds, p.mla_w_uq + (size_t)l * 384 * 384, 384, p.mla_q_norm_g + l * 384, p.wt_uq + (size_t)l * 512 * 384, 384, 1, r / 6, r % 6); continue; } r -= 48;
      transpose_tile(lds, p.mla_w_ukv + (size_t)l * 256 * 512, 512, p.mla_kv_norm_g + l * 256, p.wt_ukv + (size_t)l * 512 * 256, 256, 2, r >> 2, r & 3);
    } else if (u < 2 * TR_PER_LAYER + 192) {
      const int r = u - 2 * TR_PER_LAYER, kc = r & 7, jb = (r >> 3) % 12, l = r / 96;
      float* sl = (float*)lds;
#pragma unroll
      for (int e = 0; e < 2; ++e) { const int i = tidx() + 512 * e, bb = i >> 7, k = i & 127; const float cv = p.c[bb * 1024 + kc * 128 + k]; sl[i] = cv / (1.f + expf(-cv)); }
      __syncthreads();
      const int j = jb * 512 + tidx();
      float a0 = 0.f, a1 = 0.f, a2 = 0.f, a3 = 0.f, a4 = 0.f, a5 = 0.f, a6 = 0.f, a7 = 0.f;
      const float* w = p.w_ada + ((size_t)l * 1024 + kc * 128) * 6144 + j;
#pragma unroll 4
      for (int k = 0; k < 128; ++k) { const float wv = w[(size_t)k * 6144];
        a0 += sl[k] * wv; a1 += sl[128 + k] * wv; a2 += sl[256 + k] * wv; a3 += sl[384 + k] * wv; a4 += sl[512 + k] * wv; a5 += sl[640 + k] * wv; a6 += sl[768 + k] * wv; a7 += sl[896 + k] * wv; }
      float* d = p.modp + ((size_t)(kc * 2 + l) * 8) * 6144 + j;
      d[0] = a0; d[6144] = a1; d[2 * 6144] = a2; d[3 * 6144] = a3; d[4 * 6144] = a4; d[5 * 6144] = a5; d[6 * 6144] = a6; d[7 * 6144] = a7;
      __syncthreads();
    } else {
      const int idx = (u - 2 * TR_PER_LAYER - 192) * 512 + tidx(), pos = idx >> 4, i = idx & 15;
      double fr = 1.0; for (int k = 0; k < i; ++k) fr *= 0.56234132519034908;
      const float ang = (float)pos * (float)fr;
      double a = (double)ang; a -= 6.283185307179586476925 * __builtin_rint(a * 0.15915494309189533577);
      const double tq = a * 0.125, t2 = tq * tq;
      double sn = tq * (1.0 + t2 * (-1.0 / 6 + t2 * (1.0 / 120 + t2 * (-1.0 / 5040 + t2 * (1.0 / 362880 + t2 * (-1.0 / 39916800 + t2 * (1.0 / 6227020800.0)))))));
      double cs = 1.0 + t2 * (-0.5 + t2 * (1.0 / 24 + t2 * (-1.0 / 720 + t2 * (1.0 / 40320 + t2 * (-1.0 / 3628800 + t2 * (1.0 / 479001600.0 + t2 * (-1.0 / 87178291200.0)))))));
#pragma unroll
      for (int k = 0; k < 3; ++k) { const double s2 = 2.0 * sn * cs, c2 = cs * cs - sn * sn; sn = s2; cs = c2; }
      p.rope[(size_t)idx * 2] = (float)cs; p.rope[(size_t)idx * 2 + 1] = (float)sn;
    }
  }
}
DI void phase_prologue_b(const Params& p, int bid, int nb) {
  const int tid = tidx(), lane = tid & 63, wid = tid >> 6;
  if (bid == 0) for (int i = tid; i < 6144 + 64; i += 512) p.nmax[i] = 0u;
  for (int u = bid; u < 512 + 192; u += nb) {
    if (u < 512) {
      const int row0 = u * 64, b = row0 >> 12;
      f32x4 sh[4], sc[4];
#pragma unroll
      for (int e = 0; e < 4; ++e) { const int col = e * 256 + lane * 4;
        f32x4 a = *(const f32x4*)(p.b_ada + col), c = *(const f32x4*)(p.b_ada + 1024 + col);
        for (int kc = 0; kc < 8; ++kc) { const float* mp = p.modp + ((size_t)(kc * 2 + 0) * 8 + b) * 6144; a += *(const f32x4*)(mp + col); c += *(const f32x4*)(mp + 1024 + col); }
        sh[e] = a; sc[e] = c + 1.f; }
      for (int r = wid; r < 64; r += 8) { const size_t row = (size_t)(row0 + r);
#pragma unroll
        for (int e = 0; e < 4; ++e) { const int col = e * 256 + lane * 4; const f32x4 xv = *(const f32x4*)(p.x + row * DM + col); const f32x4 hv = xv * sc[e] + sh[e];
          st4(p.H + row * DM + col, hv[0], hv[1], hv[2], hv[3]); } }
    } else {
      const int idx = (u - 512) * 512 + tid, j = idx % 6144, lb = idx / 6144, l = lb >> 3, b = lb & 7;
      float a = p.b_ada[l * 6144 + j];
      for (int kc = 0; kc < 8; ++kc) a += p.modp[((size_t)(kc * 2 + l) * 8 + b) * 6144 + j];
      p.mod[(size_t)lb * 6144 + j] = a;
    }
  }
}
DI void phase_ln(const Params& p, const float* g, const float* bta, const float* sh, const float* sc, bool writex, int bid, int nb) {
  const int tid = tidx(), lane = tid & 63, wid = tid >> 6;
  for (int row = bid * 8 + wid; row < NTOK; row += nb * 8) {
    float* xr = p.out + (size_t)row * DM; const int b = row >> 12;
    f32x4 v[4]; float s = 0.f;
#pragma unroll
    for (int e = 0; e < 4; ++e) { v[e] = *(const f32x4*)(xr + e * 256 + lane * 4); s += (v[e][0] + v[e][1]) + (v[e][2] + v[e][3]); }
#pragma unroll
    for (int o = 32; o > 0; o >>= 1) s += __shfl_xor(s, o);
    const float mu = s * (1.f / 1024.f); float q = 0.f;
#pragma unroll
    for (int e = 0; e < 4; ++e) { v[e] -= mu; q += (v[e][0] * v[e][0] + v[e][1] * v[e][1]) + (v[e][2] * v[e][2] + v[e][3] * v[e][3]); }
#pragma unroll
    for (int o = 32; o > 0; o >>= 1) q += __shfl_xor(q, o);
    const float rstd = rsqrtf(q * (1.f / 1024.f) + 1e-5f);
    if (!writex && lane == 0) { f32x2 ms = {mu, rstd}; *(f32x2*)(p.lnstat + (size_t)row * 2) = ms; }
#pragma unroll
    for (int e = 0; e < 4; ++e) { const int col = e * 256 + lane * 4;
      const f32x4 y = v[e] * rstd * *(const f32x4*)(g + col) + *(const f32x4*)(bta + col);
      if (writex) *(f32x4*)(xr + col) = y;
      if (sh) { const f32x4 hv = y * (*(const f32x4*)(sc + b * 6144 + col) + 1.f) + *(const f32x4*)(sh + b * 6144 + col); st4(p.H + (size_t)row * DM + col, hv[0], hv[1], hv[2], hv[3]); } }
  }
}

#define XB_TMO      128
#define XB_XCNT(j)  (256  + 64 * (j))
#define XB_XSUB(j)  (1280 + 64 * (j))
#define XB_XGEN(j)  (2304 + 64 * (j))
#define XB_TOP      3328
#define XB_TOPGEN   3392
#define XCD_BAR_WORDS 3456
#define XB_SPIN_CAP (1u << 18)

__device__ __forceinline__ unsigned xb_ld(unsigned* p)              { return __hip_atomic_load(p, __ATOMIC_RELAXED, __HIP_MEMORY_SCOPE_AGENT); }
__device__ __forceinline__ unsigned xb_add(unsigned* p, unsigned v) { return __hip_atomic_fetch_add(p, v, __ATOMIC_RELAXED, __HIP_MEMORY_SCOPE_AGENT); }
__device__ __forceinline__ unsigned xb_xcc_id() { return (unsigned)__builtin_amdgcn_s_getreg((3 << 11) | 20) & 0xFu; }
#define XB_SPIN(cond, bar) do { unsigned _sp = 0; while (cond) { __builtin_amdgcn_s_sleep(1); \
    if ((++_sp & 255u) == 0u) { if (xb_ld(&(bar)[XB_TMO])) break; if (_sp > XB_SPIN_CAP) { atomicAdd(&(bar)[XB_TMO], 1u); break; } } } } while (0)

struct XcdBarrier {
    unsigned* bar; unsigned x;
    volatile LAS unsigned* st;
};

__device__ __forceinline__ XcdBarrier xcd_barrier_post(unsigned* bar, volatile LAS unsigned* st) {
    XcdBarrier b; b.bar = bar; b.x = xb_xcc_id(); b.st = st;
    if (threadIdx.x == 0) (void)xb_add(&bar[XB_XCNT(b.x)], 1u);
    return b;
}
__device__ __forceinline__ void xcd_barrier_complete(unsigned* bar, unsigned x, unsigned& nloc, unsigned& nx) {
    const unsigned G = gridDim.x * gridDim.y * gridDim.z;
    unsigned sum, cnt, mine, sp = 0u;
    for (;;) {
        sum = 0u; cnt = 0u; mine = 0u;
#pragma unroll
        for (unsigned j = 0; j < 16; ++j) { const unsigned c = xb_ld(&bar[XB_XCNT(j)]); sum += c; cnt += (c > 0u) ? 1u : 0u; mine = (j == x) ? c : mine; }
        if (sum == G) break;
        __builtin_amdgcn_s_sleep(1);
        if ((++sp & 255u) == 0u) { if (xb_ld(&bar[XB_TMO])) break; if (sp > XB_SPIN_CAP) { atomicAdd(&bar[XB_TMO], 1u); break; } }
    }
    nloc = mine > 0u ? mine : 1u; nx = cnt > 0u ? cnt : 1u;
}

__device__ __forceinline__ void xcd_barrier(const XcdBarrier& b) {
    asm volatile("s_waitcnt vmcnt(0)" ::: "memory");
    __syncthreads();
    if (threadIdx.x == 0) {
        unsigned* bar = b.bar;
        __builtin_amdgcn_s_waitcnt(0);
        unsigned nloc = b.st[0], nx = b.st[1];
        if (nloc == 0u) { xcd_barrier_complete(bar, b.x, nloc, nx); b.st[0] = nloc; b.st[1] = nx; }
        const unsigned old = xb_add(&bar[XB_XSUB(b.x)], 1u);
        const unsigned gen = old / nloc;
        if (old + 1u == (gen + 1u) * nloc) {
            __builtin_amdgcn_fence(__ATOMIC_RELEASE, "agent");
            asm volatile("s_waitcnt vmcnt(0)" ::: "memory");
            const unsigned og = xb_add(&bar[XB_TOP], 1u);
            const unsigned tg = og / nx;
            if (og + 1u == (tg + 1u) * nx) xb_add(&bar[XB_TOPGEN], 1u);
            else XB_SPIN(xb_ld(&bar[XB_TOPGEN]) == tg, bar);
            __builtin_amdgcn_fence(__ATOMIC_ACQUIRE, "agent");
            xb_add(&bar[XB_XGEN(b.x)], 1u);
            asm volatile("s_waitcnt vmcnt(0)" ::: "memory");
        } else {
            XB_SPIN(xb_ld(&bar[XB_XGEN(b.x)]) == gen, bar);
            __builtin_amdgcn_fence(__ATOMIC_ACQUIRE, "agent");
            asm volatile("s_waitcnt vmcnt(0)" ::: "memory");
        }
    }
    __syncthreads();
}


constexpr int NPHASE = 2 + 8 * 2;
DI void run_phase(const Params& p, int ph, char* lds, int bid, int nb) {
  if (ph == 0) { phase_prologue_a(lds, p, bid, nb); return; }
  if (ph == 1) { phase_prologue_b(p, bid, nb); return; }
  const int l = (ph - 2) >> 3, sp = (ph - 2) & 7;
  const float* mod = p.mod + (size_t)l * 8 * 6144;
  if (sp == 0) {
    const bf16_t* W = p.wt_in + (size_t)l * 2816 * 1024;
    const pg8::Gemm g{p.H, W, NTOK, 2816, 1024};
    __syncthreads();
    { EpiInProj8 e8{&p, l, lds + EPI8_OFF}; SkipOrder so; so.S.init(NTOK, 2560, nb, bid);
      pg8::gemm_phase<EpiInProj8, SkipOrder, true, true, false>((PG8_LAS unsigned char*)lds, g, so, e8); }
    __syncthreads();
    { EpiVt8 ev{p.vta}; const ColOrder co{2, (nb == 256 ? (bid >= 128 ? bid - 128 : bid + 128) : bid), nb};
      pg8::gemm_phase<EpiVt8, ColOrder, true, true, true>((PG8_LAS unsigned char*)lds, g, co, ev); }
    __syncthreads();
  } else if (sp == 1) {
    EpiMla<0> eq{p}; EpiMla<1> ekv{p};
    gemm_loop<false>(lds, p.proj + C_BCQ, LDP, p.wt_uq + (size_t)l * 512 * 384, 384, 384, bid, nb, 256, 2, 0, eq);
#if PROBE_DUP == 6
    gemm_loop<false>(lds, p.proj + C_BCQ, LDP, p.wt_uq + (size_t)l * 512 * 384, 384, 384, bid, nb, 256, 2, 0, eq);
#endif
    gemm_loop<false>(lds, p.proj + C_BCKV, LDP, p.wt_ukv + (size_t)l * 512 * 256, 256, 256, bid, nb, 128, 1, 0, ekv);
    gemm_loop<true>(lds, p.proj + C_BCKV, LDP, p.wt_ukv + (size_t)l * 512 * 256, 256, 256, (nb == 256 ? (bid >= 128 ? bid - 128 : bid + 128) : bid), nb, 128, 1, 1, ekv);
    attn_d6_loop(lds, p, l, bid, nb, 1536);
#if PROBE_DUP == 5
    attn_d6_loop(lds, p, l, bid, nb, 1536);
#endif
  } else if (sp == 2) {
    int* su = (int*)(lds + LDS_BYTES - 16);
    for (;;) {
      __syncthreads();
      if (tidx() == 0) *su = (int)atomicAdd(p.nmax + 6144 + l, 1u);
      __syncthreads();
      const int q = *su;
      if (q >= 2048 + 1024) break;
      if (q >= 2048) { dcombine_unit(p, q - 2048); continue; }
      if (q < 256 || q >= 1280) attn_unit<0>(lds, p, l, q < 256 ? 768 + q : 2047 - q);
      else if (q < 768) attn_unit<1>(lds, p, l, q - 256);
      else attn_unit<2>(lds, p, l, q - 768);
    }
  } else if (sp == 3) {
    const EpiResid8 epi{l == 0 ? p.x : p.out, p.out, mod + 2 * 1024, l == 0 ? nullptr : p.lnstat, p.ln_mlp_g + (l - (l > 0)) * 1024, p.ln_mlp_b + (l - (l > 0)) * 1024, lds + EPI8_OFF};
    const pg8::Gemm g{p.Y, p.wt_o + (size_t)l * 1024 * 1024, NTOK, 1024, 1024};
    pg8::StaticOrder S; S.init(NTOK, 1024, nb, bid);
    __syncthreads();
    pg8::gemm_phase<EpiResid8, pg8::StaticOrder, true, true, false>((PG8_LAS unsigned char*)lds, g, S, epi);
    __syncthreads();
  } else if (sp == 4) {
    phase_ln(p, p.ln_attn_g + l * 1024, p.ln_attn_b + l * 1024, mod + 3 * 1024, mod + 4 * 1024, false, bid, nb);
  } else if (sp == 5) {
    const EpiUp8 epi{p.U, lds + EPI8_OFF};
    const pg8::Gemm g{p.H, p.wt_up + (size_t)l * 4096 * 1024, NTOK, 4096, 1024};
    pg8::StaticOrder S; S.init(NTOK, 4096, nb, bid);
    __syncthreads();
    pg8::gemm_phase<EpiUp8, pg8::StaticOrder, true, true, false>((PG8_LAS unsigned char*)lds, g, S, epi);
    __syncthreads();
  } else if (sp == 6) {
    const EpiResid8 epi{p.out, p.out, mod + 5 * 1024, p.lnstat, p.ln_attn_g + l * 1024, p.ln_attn_b + l * 1024, lds + EPI8_OFF};
    const pg8::Gemm g{p.U, p.wt_down + (size_t)l * 1024 * 4096, NTOK, 1024, 4096};
    pg8::StaticOrder S; S.init(NTOK, 1024, nb, bid);
    __syncthreads();
    pg8::gemm_phase<EpiResid8, pg8::StaticOrder, true, true, false>((PG8_LAS unsigned char*)lds, g, S, epi);
    __syncthreads();
  } else {
    const float* nmod = p.mod + (size_t)(l + 1) * 8 * 6144;
    if (bid == 0 && l == 0) for (int i = tidx(); i < 6144; i += 512) p.nmax[i] = 0u;
    phase_ln(p, p.ln_mlp_g + l * 1024, p.ln_mlp_b + l * 1024, l == 0 ? nmod : nullptr, l == 0 ? nmod + 1024 : nullptr, l == 1, bid, nb);
  }
}

#if MULTI_LAUNCH
template <int PH> __global__ void __launch_bounds__(512) k_ph(Params p) {
  __shared__ __attribute__((aligned(16))) char smem[LDS_BYTES];
  run_phase(p, PH, smem, blockIdx.x, gridDim.x);
}
#else
__global__ void __launch_bounds__(512) k_mega(Params p) {
  __shared__ __attribute__((aligned(16))) char smem[LDS_BYTES + 8 * EPI8_IMG + 64];
  cg::grid_group grid = cg::this_grid();
  volatile LAS unsigned* st = (volatile LAS unsigned*)(LAS char*)(smem + LDS_BYTES + 8 * EPI8_IMG);
  if (threadIdx.x < 2) st[threadIdx.x] = 0u;
  __syncthreads();
  const XcdBarrier xb = xcd_barrier_post(p.bar, st);
#define GSYNC_ xcd_barrier(xb)
#define PH_(n) run_phase(p, n, smem, blockIdx.x, gridDim.x)
  PH_(0); grid.sync(); PH_(1); GSYNC_;
  PH_(2); GSYNC_; PH_(3); GSYNC_; PH_(4); GSYNC_; PH_(5); GSYNC_; PH_(6); GSYNC_; PH_(7); GSYNC_; PH_(8); GSYNC_; PH_(9); GSYNC_;
  PH_(10); GSYNC_; PH_(11); GSYNC_; PH_(12); GSYNC_; PH_(13); GSYNC_; PH_(14); GSYNC_; PH_(15); GSYNC_; PH_(16); GSYNC_; PH_(17);
#if PROBE_DUP == 7
  for (int i_ = 0; i_ < 10; ++i_) GSYNC_;
#endif
#undef PH_
}
#endif

extern "C" void kernel_launch(void* const* d_in, const int* in_sizes, int n_in, void* d_out, int out_size, void* d_ws, size_t ws_size, hipStream_t stream) {
  Params p{};
  const float** f = (const float**)&p;
  for (int i = 0; i < 20; ++i) f[i] = (const float*)d_in[i];
  p.out = (float*)d_out;
  char* w = (char*)d_ws; size_t o = 0;
  auto take = [&](size_t bytes) { char* r = w + o; o += (bytes + 255) & ~(size_t)255; return r; };
  p.wt_in = (bf16_t*)take((size_t)2 * 2816 * 1024 * 2);
  p.wt_o = (bf16_t*)take((size_t)2 * 1024 * 1024 * 2);
  p.wt_up = (bf16_t*)take((size_t)2 * 4096 * 1024 * 2);
  p.wt_down = (bf16_t*)take((size_t)2 * 4096 * 1024 * 2);
  p.wt_uq = (bf16_t*)take((size_t)2 * 512 * 384 * 2);
  p.wt_ukv = (bf16_t*)take((size_t)2 * 512 * 256 * 2);
  p.modp = (float*)take((size_t)8 * 2 * 8 * 6144 * 4);
  p.mod = (float*)take((size_t)2 * 8 * 6144 * 4);
  p.rope = (float*)take((size_t)4096 * 16 * 2 * 4);
  p.ssq = (float*)take((size_t)NTOK * 16 * 4);
  p.dlse = (float*)take((size_t)3 * NTOK * 4 * 4);
  p.lnstat = (float*)take((size_t)NTOK * 2 * 4);
  p.bar = (unsigned*)take((size_t)XCD_BAR_WORDS * 4);
  p.nmax = (unsigned*)take((size_t)(6144 + 64) * 4);
  p.H = (bf16_t*)take((size_t)NTOK * 1024 * 2);
  p.dpart = p.H;
  char* R = w + o;
  p.proj = (bf16_t*)take((size_t)NTOK * LDP * 2);
  p.qb = (bf16_t*)take((size_t)NTOK * 384 * 2);
  p.knb = (bf16_t*)take((size_t)NTOK * 256 * 2);
  p.vta = (bf16_t*)take((size_t)8 * 4 * 64 * 4096 * 2);
  p.vtb = (bf16_t*)take((size_t)8 * 4 * 64 * 4096 * 2);
  p.vtc = (bf16_t*)take((size_t)8 * 2 * 64 * 4096 * 2);
  p.Y = (bf16_t*)take((size_t)NTOK * 1024 * 2);
  p.U = (bf16_t*)R;
  static int grid_blocks = 0;
#if MULTI_LAUNCH
  grid_blocks = 256;
#define L_(n) hipLaunchKernelGGL(k_ph<n>, dim3(grid_blocks), dim3(512), 0, stream, p)
  L_(0); L_(1); L_(2); L_(3); L_(4); L_(5); L_(6); L_(7); L_(8); L_(9); L_(10); L_(11); L_(12); L_(13); L_(14); L_(15); L_(16); L_(17);
#undef L_
#else
  if (!grid_blocks) { int dev = 0, cus = 0, per_cu = 0; hipGetDevice(&dev); hipDeviceGetAttribute(&cus, hipDeviceAttributeMultiprocessorCount, dev);
    hipOccupancyMaxActiveBlocksPerMultiprocessor(&per_cu, k_mega, 512, 0); if (per_cu < 1) per_cu = 1; grid_blocks = cus * per_cu; }
  hipMemsetAsync(p.bar, 0, (size_t)XCD_BAR_WORDS * 4, stream);
  void* args[] = {&p};
  hipError_t e = hipLaunchCooperativeKernel((void*)k_mega, dim3(grid_blocks), dim3(512), args, 0, stream);
  if (e != hipSuccess) fprintf(stderr, "cooperative launch failed: %s (grid %d)\n", hipGetErrorString(e), grid_blocks);
#endif
}
```
